# Optimizing an MI355X kernel written in HIP

```python
import jax, jax.numpy as jnp
from jax import lax
import numpy as np

D_MODEL = 1024
BATCH = 8
SEQ = 8192
DEPTH = 4

HEAD_DIM = 64
N_FOX_HEADS = D_MODEL // (2 * HEAD_DIM)
N_RWKV_HEADS = D_MODEL // (2 * HEAD_DIM)
FOX_WIDTH = N_FOX_HEADS * HEAD_DIM
RWKV_WIDTH = N_RWKV_HEADS * HEAD_DIM
DECAY_LORA = 64
ICLR_LORA = 64
GATE_LORA = 128
RWKV_IN = 3 * RWKV_WIDTH + DECAY_LORA + ICLR_LORA + GATE_LORA
FOX_IN = 3 * FOX_WIDTH + N_FOX_HEADS
EVEN_IN = FOX_IN + RWKV_IN
RWKV_SPLITS = [RWKV_WIDTH, 2 * RWKV_WIDTH, 3 * RWKV_WIDTH,
               3 * RWKV_WIDTH + DECAY_LORA, 3 * RWKV_WIDTH + DECAY_LORA + ICLR_LORA]
N_DIL_HEADS = D_MODEL // HEAD_DIM
DIL_WIDTH = N_DIL_HEADS * HEAD_DIM
ODD_IN = 3 * DIL_WIDTH
DILATED_GROUPS = ((128, 1), (512, 4), (2048, 16))
ROPE_THETA = 500000.0
ROPE_DIMS = HEAD_DIM // 4
D_FF = ((8 * D_MODEL // 3 + 127) // 128) * 128
CONV_WIDTH = 3
Q_BLOCK = 128
RMS_EPS = 1e-6
GN_EPS = 64e-5
NEG_INF = -1e30
N_EVEN = (DEPTH + 1) // 2
N_ODD = DEPTH // 2

kernel_name = "fox_rwkv7_dilated_hybrid"


def rms_norm(x, g):
    xf = x.astype(jnp.float32)
    y = xf * lax.rsqrt(jnp.mean(xf * xf, axis=-1, keepdims=True) + RMS_EPS)
    return (y * g.astype(jnp.float32)).astype(x.dtype)


def shift_right(t):
    return jnp.pad(t, ((0, 0), (1, 0), (0, 0)))[:, :-1]


def rotary_tables(positions):
    inv_freq = ROPE_THETA ** (-jnp.arange(0, ROPE_DIMS, 2, dtype=jnp.float32) / ROPE_DIMS)
    ang = positions.astype(jnp.float32)[..., None] * inv_freq
    return jnp.cos(ang)[:, :, None, :], jnp.sin(ang)[:, :, None, :]


def partial_rotary(t, cos, sin):
    half = ROPE_DIMS // 2
    t1, t2 = t[..., :half], t[..., half:ROPE_DIMS]
    rot = jnp.concatenate([t1 * cos - t2 * sin, t1 * sin + t2 * cos], axis=-1).astype(t.dtype)
    return jnp.concatenate([rot, t[..., ROPE_DIMS:]], axis=-1)


def forgetting_attention(q, k, v, log_f):
    B, T, H, Dh = q.shape
    nb = T // Q_BLOCK
    scale = Dh ** -0.5
    c = jnp.cumsum(log_f, axis=1)
    c_k = c.transpose(0, 2, 1)[:, :, None, :]
    k_pos = jnp.arange(T)
    qb = q.reshape(B, nb, Q_BLOCK, H, Dh).transpose(1, 0, 2, 3, 4)
    cb = c.reshape(B, nb, Q_BLOCK, H).transpose(1, 0, 2, 3)

    def block(args):
        q_blk, c_blk, i = args
        s = jnp.einsum('bqhd,bkhd->bhqk', q_blk, k, preferred_element_type=jnp.float32) * scale
        s = s + c_blk.transpose(0, 2, 1)[..., None] - c_k
        q_pos = i * Q_BLOCK + jnp.arange(Q_BLOCK)
        s = jnp.where(q_pos[:, None] >= k_pos[None, :], s, NEG_INF)
        p = jax.nn.softmax(s, axis=-1)
        return jnp.einsum('bhqk,bkhd->bqhd', p.astype(v.dtype), v)

    o = lax.map(block, (qb, cb, jnp.arange(nb)))
    return o.transpose(1, 0, 2, 3, 4).reshape(B, T, H, Dh)


def rwkv7_scan(r, w, k, v, a, b):
    B, T, H, N = r.shape

    def step(S, inp):
        r_t, w_t, k_t, v_t, a_t, b_t = inp
        sa = jnp.einsum('bhvk,bhk->bhv', S, a_t)
        S = S * w_t[:, :, None, :] + sa[..., None] * b_t[:, :, None, :] + v_t[..., None] * k_t[:, :, None, :]
        return S, jnp.einsum('bhvk,bhk->bhv', S, r_t)

    xs = tuple(t.transpose(1, 0, 2, 3) for t in (r, w, k, v, a, b))
    _, y = lax.scan(step, jnp.zeros((B, H, N, N), jnp.float32), xs)
    return y.transpose(1, 0, 2, 3)


def rwkv7_time_mix(z, mu, w0, w2, a0, a2, g2, k_k, k_a, r_k, ln_w, ln_b):
    B, T, _ = z.shape
    H, N = N_RWKV_HEADS, HEAD_DIM
    heads = lambda t: t.reshape(B, T, H, N)
    z = z.astype(jnp.float32)
    z = z + (shift_right(z) - z) * mu
    r, k, v, w_lo, a_lo, g_lo = jnp.split(z, RWKV_SPLITS, axis=-1)
    w = -jax.nn.softplus(-(w0 + jnp.tanh(w_lo) @ w2)) - 0.5
    decay = jnp.exp(-jnp.exp(w))
    a = jax.nn.sigmoid(a0 + a_lo @ a2)
    g = jax.nn.sigmoid(g_lo) @ g2
    kk = heads(k * k_k)
    kk = kk / jnp.maximum(jnp.sqrt(jnp.sum(kk * kk, axis=-1, keepdims=True)), 1e-12)
    k = k * (1 + (a - 1) * k_a)
    y = rwkv7_scan(heads(r), heads(decay), heads(k), heads(v), -kk, kk * heads(a))
    mean = jnp.mean(y, axis=-1, keepdims=True)
    var = jnp.mean(jnp.square(y - mean), axis=-1, keepdims=True)
    y = ((y - mean) * lax.rsqrt(var + GN_EPS)).reshape(B, T, RWKV_WIDTH) * ln_w + ln_b
    bonus = jnp.sum(heads(r) * heads(k) * r_k, axis=-1, keepdims=True) * heads(v)
    return (y + bonus.reshape(B, T, RWKV_WIDTH)) * g


def fox_rwkv_mixer(h, w_in, forget_bias, mu, w0, w2, a0, a2, g2, k_k, k_a, r_k, ln_w, ln_b, w_out):
    B, T, _ = h.shape
    z = h @ w_in
    fz, rz = z[..., :FOX_IN], z[..., FOX_IN:]
    q, k, v = [fz[..., i * FOX_WIDTH:(i + 1) * FOX_WIDTH].reshape(B, T, N_FOX_HEADS, HEAD_DIM)
               for i in range(3)]
    log_f = jax.nn.log_sigmoid((fz[..., 3 * FOX_WIDTH:] + forget_bias).astype(jnp.float32))
    y_fox = forgetting_attention(q, k, v, log_f).reshape(B, T, FOX_WIDTH)
    y_rwkv = rwkv7_time_mix(rz, mu, w0, w2, a0, a2, g2, k_k, k_a, r_k, ln_w, ln_b)
    y = jnp.concatenate([y_fox, y_rwkv.astype(y_fox.dtype)], axis=-1)
    return y @ w_out


def dilated_branch(q, k, v, window, dilation):
    B, T, H, Dh = q.shape
    span = window // dilation
    L = T // dilation
    nb = -(-L // span)
    Lp = nb * span
    scale = Dh ** -0.5

    def to_blocks(t):
        t = t.reshape(B, L, dilation, H, Dh).transpose(2, 0, 1, 3, 4)
        t = jnp.pad(t, ((0, 0), (0, 0), (0, Lp - L), (0, 0), (0, 0)))
        return t.reshape(dilation, B, nb, span, H, Dh)

    def band(t):
        prev = jnp.pad(t[:, :, :-1], ((0, 0), (0, 0), (1, 0), (0, 0), (0, 0), (0, 0)))
        return jnp.concatenate([prev, t], axis=3)

    def flat(t):
        t = jnp.swapaxes(t, 1, 2)
        return t.reshape((dilation * nb,) + t.shape[2:])

    qf = flat(to_blocks(q))
    kf = flat(band(to_blocks(k)))
    vf = flat(band(to_blocks(v)))
    blk_n = jnp.tile(jnp.arange(nb), dilation)
    qi = jnp.arange(span)[:, None]
    ki = jnp.arange(2 * span)[None, :]
    delta = qi - ki + span
    band_mask = (delta >= 0) & (delta <= span)

    def one(args):
        qx, kx, vx, n = args
        s = jnp.einsum('bqhd,bkhd->bhqk', qx, kx, preferred_element_type=jnp.float32) * scale
        valid = band_mask & ((ki >= span) | (n > 0))
        s = jnp.where(valid, s, NEG_INF)
        m = jnp.max(s, axis=-1, keepdims=True)
        e = jnp.exp(s - m)
        den = jnp.sum(e, axis=-1, keepdims=True)
        o = jnp.einsum('bhqk,bkhd->bqhd', (e / den).astype(vx.dtype), vx)
        return o, (m + jnp.log(den))[..., 0]

    o, lse = lax.map(one, (qf, kf, vf, blk_n))
    o = o.reshape(dilation, nb, B, span, H, Dh).transpose(2, 1, 3, 0, 4, 5)
    o = o.reshape(B, Lp, dilation, H, Dh)[:, :L].reshape(B, T, H, Dh)
    lse = lse.reshape(dilation, nb, B, H, span).transpose(2, 1, 4, 0, 3)
    lse = lse.reshape(B, Lp, dilation, H)[:, :L].reshape(B, T, H)
    return o, lse


def dilated_mixer(h, w_in, w_out, cos, sin):
    B, T, _ = h.shape
    z = h @ w_in
    q, k, v = [z[..., i * DIL_WIDTH:(i + 1) * DIL_WIDTH].reshape(B, T, N_DIL_HEADS, HEAD_DIM)
               for i in range(3)]
    q = partial_rotary(q, cos, sin)
    k = partial_rotary(k, cos, sin)
    outs, lses = zip(*[dilated_branch(q, k, v, w, d) for (w, d) in DILATED_GROUPS])
    wts = jax.nn.softmax(jnp.stack(lses, axis=0), axis=0)
    o = jnp.sum(wts[..., None] * jnp.stack(outs, axis=0).astype(jnp.float32), axis=0)
    return o.reshape(B, T, DIL_WIDTH).astype(h.dtype) @ w_out


def conv_ffn(h, w_up, conv_w, conv_b, w_down):
    T = h.shape[1]
    u = h @ w_up
    up = jnp.pad(u, ((0, 0), (CONV_WIDTH - 1, 0), (0, 0)))
    acc = conv_b
    for j in range(CONV_WIDTH):
        acc = acc + conv_w[j] * up[:, j:j + T]
    gate, val = jnp.split(acc, 2, axis=-1)
    return (jax.nn.gelu(gate, approximate=True) * val) @ w_down


def setup_inputs(seed: int = 0) -> dict:
    key = jax.random.key(seed)
    ks = iter(jax.random.split(key, 32))
    nrm = lambda shape, scale: jax.random.normal(next(ks), shape, jnp.float32) * scale
    uni = lambda shape, lo, hi: jax.random.uniform(next(ks), shape, jnp.float32, lo, hi)
    x = jax.random.normal(next(ks), (BATCH, SEQ, D_MODEL), jnp.float32)
    offsets = jax.random.randint(next(ks), (BATCH, 1), 0, 4096, dtype=jnp.int32)
    positions = (jnp.arange(SEQ, dtype=jnp.int32)[None, :] + offsets).astype(jnp.int32)
    conv_w = jnp.zeros((DEPTH, CONV_WIDTH, 2 * D_FF), jnp.float32).at[:, -1].set(1.0) \
        + nrm((DEPTH, CONV_WIDTH, 2 * D_FF), 0.1)
    return {
        "x": x,
        "positions": positions,
        "norm_mix_pre": 1.0 + nrm((DEPTH, D_MODEL), 0.02),
        "norm_mix_post": 1.0 + nrm((DEPTH, D_MODEL), 0.02),
        "norm_ffn_pre": 1.0 + nrm((DEPTH, D_MODEL), 0.02),
        "norm_ffn_post": 1.0 + nrm((DEPTH, D_MODEL), 0.02),
        "even_w_in": nrm((N_EVEN, D_MODEL, EVEN_IN), D_MODEL ** -0.5),
        "fox_forget_bias": uni((N_EVEN, N_FOX_HEADS), 2.0, 5.0),
        "rwkv_mu": uni((N_EVEN, RWKV_IN), 0.0, 1.0),
        "rwkv_w0": uni((N_EVEN, RWKV_WIDTH), -6.0, 1.0),
        "rwkv_w2": nrm((N_EVEN, DECAY_LORA, RWKV_WIDTH), 0.5 * DECAY_LORA ** -0.5),
        "rwkv_a0": nrm((N_EVEN, RWKV_WIDTH), 0.1),
        "rwkv_a2": nrm((N_EVEN, ICLR_LORA, RWKV_WIDTH), 0.5 * ICLR_LORA ** -0.5),
        "rwkv_g2": nrm((N_EVEN, GATE_LORA, RWKV_WIDTH), GATE_LORA ** -0.5),
        "rwkv_k_k": 0.85 + nrm((N_EVEN, RWKV_WIDTH), 0.05),
        "rwkv_k_a": 1.0 + nrm((N_EVEN, RWKV_WIDTH), 0.05),
        "rwkv_r_k": nrm((N_EVEN, N_RWKV_HEADS, HEAD_DIM), 0.1),
        "rwkv_ln_w": 1.0 + nrm((N_EVEN, RWKV_WIDTH), 0.02),
        "rwkv_ln_b": nrm((N_EVEN, RWKV_WIDTH), 0.02),
        "even_w_out": nrm((N_EVEN, FOX_WIDTH + RWKV_WIDTH, D_MODEL), (FOX_WIDTH + RWKV_WIDTH) ** -0.5),
        "odd_w_in": nrm((N_ODD, D_MODEL, ODD_IN), D_MODEL ** -0.5),
        "odd_w_out": nrm((N_ODD, DIL_WIDTH, D_MODEL), DIL_WIDTH ** -0.5),
        "ffn_w_up": nrm((DEPTH, D_MODEL, 2 * D_FF), D_MODEL ** -0.5),
        "ffn_conv_w": conv_w,
        "ffn_conv_b": nrm((DEPTH, 2 * D_FF), 0.02),
        "ffn_w_down": nrm((DEPTH, D_FF, D_MODEL), D_FF ** -0.5),
    }


def reference(x, positions, norm_mix_pre, norm_mix_post, norm_ffn_pre, norm_ffn_post,
              even_w_in, fox_forget_bias, rwkv_mu, rwkv_w0, rwkv_w2, rwkv_a0, rwkv_a2, rwkv_g2,
              rwkv_k_k, rwkv_k_a, rwkv_r_k, rwkv_ln_w, rwkv_ln_b, even_w_out,
              odd_w_in, odd_w_out, ffn_w_up, ffn_conv_w, ffn_conv_b, ffn_w_down):
    cos, sin = rotary_tables(positions)
    for layer in range(DEPTH):
        i = layer // 2
        h = rms_norm(x, norm_mix_pre[layer])
        if layer % 2 == 0:
            m = fox_rwkv_mixer(h, even_w_in[i], fox_forget_bias[i], rwkv_mu[i], rwkv_w0[i],
                               rwkv_w2[i], rwkv_a0[i], rwkv_a2[i], rwkv_g2[i], rwkv_k_k[i],
                               rwkv_k_a[i], rwkv_r_k[i], rwkv_ln_w[i], rwkv_ln_b[i], even_w_out[i])
        else:
            m = dilated_mixer(h, odd_w_in[i], odd_w_out[i], cos, sin)
        x = x + rms_norm(m, norm_mix_post[layer]).astype(x.dtype)
        h = rms_norm(x, norm_ffn_pre[layer])
        f = conv_ffn(h, ffn_w_up[layer], ffn_conv_w[layer], ffn_conv_b[layer], ffn_w_down[layer])
        x = x + rms_norm(f, norm_ffn_post[layer]).astype(x.dtype)
    return x
```

```cpp
#include <hip/hip_runtime.h>
#include <hip/hip_cooperative_groups.h>
#include <cstdio>
#include <cstdint>
#include <cmath>
namespace cg = cooperative_groups;
namespace pg8 {
#define PG8_LAS __attribute__((address_space(3)))
typedef unsigned short bf16_t;
typedef short bf16x8 __attribute__((ext_vector_type(8)));
typedef float f32x4 __attribute__((ext_vector_type(4)));
typedef unsigned u32x4 __attribute__((ext_vector_type(4)));
constexpr int BM = 256, BK = 64, HALF = 128, HTB = HALF * BK * 2  , STAGE_BYTES = 8 * HTB, NXCD = 8, WGM = 8;

__host__ __device__ __forceinline__ int lds_byte(int r, int c) { const int st = (r >> 4) * 2 + (c >> 5), rr = r & 15, cc = c & 31, ob = rr * 64 + cc * 2; return st * 1024 + (ob ^ (((ob >> 9) & 1) << 5)); }
__host__ __device__ __forceinline__ void stage_rc(int b, int& R, int& C) { const int st = b / 1024, sb = b % 1024, swz = sb ^ (((sb >> 9) & 1) << 5); R = (st >> 1) * 16 + swz / 64; C = (st & 1) * 32 + (swz % 64) / 2; }
__host__ __device__ __forceinline__ int perm32(int rho) { const int n = rho >> 4, i = rho & 15; return 8 * (i >> 2) + 4 * n + (i & 3); }

struct Unit { int pm, pn; };
struct Gemm { const bf16_t* A; const bf16_t* Bt; int M, N, K; int halo; };
__device__ __forceinline__ const char* a_ptr(const Gemm& g, int pm, size_t tstep) { if (g.halo) { const long row0 = (long)(pm / 33) * 8192 + (long)(pm % 33) * 254 - 2; return (const char*)g.A + row0 * (long)g.K * 2; } return (const char*)g.A + (size_t)pm * tstep; }

struct StaticOrder {
    int nM, nN, nwg, G, c;
    __host__ __device__ void init(int M, int N, int G_, int c_) { nM = M / BM; nN = N / BM; nwg = nM * nN; G = G_; c = c_; }
    __host__ __device__ bool next(int i, Unit& u) const {
        const long L = (long)i * G + c; if (L >= nwg) return false;
        int wgid = (int)L; { const int q = nwg / NXCD, r = nwg % NXCD, xcd = wgid % NXCD, off = wgid / NXCD; wgid = (xcd < r ? xcd * (q + 1) : r * (q + 1) + (xcd - r) * q) + off; }
        const int nig = WGM * nN, gid = wgid / nig, fm = gid * WGM, gsz = (nM - fm) < WGM ? (nM - fm) : WGM;
        u.pm = fm + ((wgid % nig) % gsz); u.pn = (wgid % nig) / gsz; return true;
    }
    __device__ __forceinline__ void a_ready(const Unit&) const {}
    __device__ __forceinline__ void done(const Unit&) const {}
};


typedef float f32x2 __attribute__((ext_vector_type(2)));
typedef __bf16 bf16x2_t __attribute__((ext_vector_type(2)));
__device__ __forceinline__ unsigned cvt_pk_bf16(float lo, float hi) { f32x2 v = {lo, hi}; bf16x2_t b = __builtin_convertvector(v, bf16x2_t); return __builtin_bit_cast(unsigned, b); }
template <int CTRL> __device__ __forceinline__ float dpp_old(float oldv, float x) { return __builtin_bit_cast(float, __builtin_amdgcn_update_dpp(__builtin_bit_cast(int, oldv), __builtin_bit_cast(int, x), CTRL, 0xf, 0xf, false)); }
template <int CTRL> __device__ __forceinline__ float dppf(float x) { return __builtin_bit_cast(float, __builtin_amdgcn_mov_dpp(__builtin_bit_cast(int, x), CTRL, 0xf, 0xf, true)); }

struct EpiZ {
    static constexpr bool PERM = true, AFTER_DRAIN = false;
    bf16_t* O; int ldc; int ncols; const float* cs; int rot_cols;
    __device__ __forceinline__ void operator()(const f32x4 (&acc)[2][2][4][2], const Unit& u, int wr, int wc, int fr, int fq) const {
        const int row0 = u.pm * BM + wr * 64 + fr;
#pragma unroll
        for (int bj = 0; bj < 2; ++bj) {
            const int col = u.pn * BM + bj * HALF + wc * 32 + 8 * fq;
            if (col >= ncols) continue;
            const bool rot = (cs != nullptr) && (col < rot_cols) && ((col & 63) < 16);
#pragma unroll
            for (int ai = 0; ai < 2; ++ai)
#pragma unroll
                for (int m = 0; m < 4; ++m) {
                    const int row = row0 + ai * HALF + m * 16;
                    f32x4 v0 = acc[ai][bj][m][0], v1 = acc[ai][bj][m][1];
                    if (rot) {
                        const float* t = cs + (size_t)row * 16 + ((col & 63) >> 1);
                        const f32x4 c4 = *(const f32x4*)t, s4 = *(const f32x4*)(t + 8);
                        f32x4 w0, w1;
                        w0[0] = v0[0] * c4[0] - v0[1] * s4[0]; w0[1] = v0[0] * s4[0] + v0[1] * c4[0];
                        w0[2] = v0[2] * c4[1] - v0[3] * s4[1]; w0[3] = v0[2] * s4[1] + v0[3] * c4[1];
                        w1[0] = v1[0] * c4[2] - v1[1] * s4[2]; w1[1] = v1[0] * s4[2] + v1[1] * c4[2];
                        w1[2] = v1[2] * c4[3] - v1[3] * s4[3]; w1[3] = v1[2] * s4[3] + v1[3] * c4[3];
                        v0 = w0; v1 = w1;
                    }
                    u32x4 w; w.x = cvt_pk_bf16(v0[0], v0[1]); w.y = cvt_pk_bf16(v0[2], v0[3]); w.z = cvt_pk_bf16(v1[0], v1[1]); w.w = cvt_pk_bf16(v1[2], v1[3]);
                    *(u32x4*)(O + (size_t)row * ldc + col) = w;
                }
        }
    }
};

struct EpiF32 {
    static constexpr bool PERM = false, AFTER_DRAIN = false;
    float* O; int ldc;
    __device__ __forceinline__ void operator()(const f32x4 (&acc)[2][2][4][2], const Unit& u, int wr, int wc, int fr, int fq) const {
        const int row0 = u.pm * BM + wr * 64 + fr, col0 = u.pn * BM + wc * 32 + 4 * fq;
#pragma unroll
        for (int ai = 0; ai < 2; ++ai)
#pragma unroll
            for (int m = 0; m < 4; ++m) {
                float* rowp = O + (size_t)(row0 + ai * HALF + m * 16) * ldc + col0;
#pragma unroll
                for (int bj = 0; bj < 2; ++bj)
#pragma unroll
                    for (int n = 0; n < 2; ++n) *(f32x4*)(rowp + bj * HALF + n * 16) = acc[ai][bj][m][n];
            }
    }
};

struct EpiConv {
    static constexpr bool PERM = true, AFTER_DRAIN = false;
    bf16_t* O; const float* cw; const float* cb; PG8_LAS float* X;
    __device__ __forceinline__ void operator()(const f32x4 (&acc)[2][2][4][2], const Unit& u, int wr, int wc, int fr, int fq) const {
        int xw = wr * 512 + wc * 128 + fq * 8 + (fr & 1), xr = (wr == 1 ? 0 : 512 - 1024) + wc * 128 + fq * 8;
        asm volatile("" : "+v"(xw), "+v"(xr));
        PG8_LAS float* Xw = X + xw; const PG8_LAS float* Xr = X + xr;
#pragma unroll
        for (int ai = 0; ai < 2; ++ai)
#pragma unroll
            for (int bj = 0; bj < 2; ++bj)
#pragma unroll
                for (int n = 0; n < 2; ++n)
#pragma unroll
                    for (int j = 0; j < 4; ++j)
                        if (fr >= 14) Xw[ai * 1024 + bj * 64 + n * 32 + j * 2] = acc[ai][bj][3][n][j];
        asm volatile("s_waitcnt lgkmcnt(0)" ::: "memory"); __builtin_amdgcn_s_barrier(); asm volatile("" ::: "memory");
        const int b = u.pm / 33, it = u.pm % 33;
        const int tbase = 254 * it - 2 + wr * 64 + fr;
        const bool zsrc = (it == 0) && (wr == 0) && (fr < 2);
        const int rrmax = (it == 32) ? 66 : 256;
#pragma unroll
        for (int n = 0; n < 2; ++n) {
            asm volatile("" ::: "memory");
            const int ch = u.pn * HALF + wc * 32 + 8 * fq + 4 * n;
            const f32x4 gw0 = *(const f32x4*)(cw + ch), gw1 = *(const f32x4*)(cw + 5632 + ch), gw2 = *(const f32x4*)(cw + 2 * 5632 + ch), gb = *(const f32x4*)(cb + ch);
            const f32x4 vw0 = *(const f32x4*)(cw + 2816 + ch), vw1 = *(const f32x4*)(cw + 5632 + 2816 + ch), vw2 = *(const f32x4*)(cw + 2 * 5632 + 2816 + ch), vb = *(const f32x4*)(cb + 2816 + ch);
#pragma unroll
            for (int ai = 0; ai < 2; ++ai) {
                f32x4 gP1, gP2, vP1, vP2;
                if (ai == 0 && wr == 0) { gP1 = gP2 = vP1 = vP2 = (f32x4){0.f, 0.f, 0.f, 0.f}; }
                else {
#pragma unroll
                    for (int j = 0; j < 4; ++j) {
                        const f32x2 ge = *(const PG8_LAS f32x2*)&Xr[ai * 1024 + 0 * 64 + n * 32 + j * 2];
                        const f32x2 ve = *(const PG8_LAS f32x2*)&Xr[ai * 1024 + 1 * 64 + n * 32 + j * 2];
                        gP1[j] = ge.y; gP2[j] = (fr == 0) ? ge.x : ge.y; vP1[j] = ve.y; vP2[j] = (fr == 0) ? ve.x : ve.y;
                    }
                }
#pragma unroll
                for (int m = 0; m < 4; ++m) {
                    f32x4 g = acc[ai][0][m][n], v = acc[ai][1][m][n];
                    if (ai == 0 && m == 0) { if (zsrc) { g = (f32x4){0.f, 0.f, 0.f, 0.f}; v = g; } }
                    f32x4 a4;
#pragma unroll
                    for (int j = 0; j < 4; ++j) {
                        const float g1 = dpp_old<0x111>(gP1[j], g[j]), g2 = dpp_old<0x112>(gP2[j], g[j]), v1 = dpp_old<0x111>(vP1[j], v[j]), v2 = dpp_old<0x112>(vP2[j], v[j]);
                        const float gc = gb[j] + gw0[j] * g2 + gw1[j] * g1 + gw2[j] * g[j];
                        const float vc = vb[j] + vw0[j] * v2 + vw1[j] * v1 + vw2[j] * v[j];
                        const float y2 = gc * (1.0f + 0.044715f * gc * gc) * (2.0f * 0.7978845608028654f * 1.4426950408889634f);
                        const float e = __builtin_amdgcn_exp2f(y2);
                        const float ge_ = gc - gc * __builtin_amdgcn_rcpf(1.0f + e);
                        a4[j] = ge_ * vc;
                        gP1[j] = dppf<0x121>(g[j]); vP1[j] = dppf<0x121>(v[j]); gP2[j] = dppf<0x122>(g[j]); vP2[j] = dppf<0x122>(v[j]);
                    }
                    const int rr = wr * 64 + fr + ai * HALF + m * 16;
                    if (rr >= 2 && rr < rrmax) {
                        typedef unsigned u32x2 __attribute__((ext_vector_type(2)));
                        u32x2 w; w.x = cvt_pk_bf16(a4[0], a4[1]); w.y = cvt_pk_bf16(a4[2], a4[3]);
                        *(u32x2*)(O + ((size_t)b * 8192 + (tbase + ai * HALF + m * 16)) * 2816 + ch) = w;
                    }
                }
            }
        }
    }
};
template <class Epi, class Sched, bool ALIGN_EPI = false, bool SP2 = false>
__device__ __forceinline__ void gemm_phase(PG8_LAS unsigned char* lds, const Gemm g, const Sched& S, const Epi& E, const int tid_in) {
    const int tid = tid_in, wid = __builtin_amdgcn_readfirstlane(tid >> 6), lane = tid & 63, wr = wid >> 2, wc = wid & 3, fr = lane & 15, fq = lane >> 4;
    const int K = g.K, nt = K / BK;
    unsigned voffA[2], voffB[2];
#pragma unroll
    for (int i = 0; i < 2; ++i) { int R, C; stage_rc(tid * 16 + i * 8192, R, C); const int Rb = Epi::PERM ? ((R & ~31) + perm32(R & 31)) : R;
        voffA[i] = (unsigned)(R * K + C) * 2u; voffB[i] = (unsigned)(Rb * K + C) * 2u; }
    const size_t kstep = (size_t)(BK * 2);
    const size_t hstep = (size_t)HALF * K * 2;
    const size_t tstep = 2 * hstep;
    const unsigned ldsw = (unsigned)wid * 1024u;
    const int aoff = lds_byte(wr * 64 + fr, fq * 8), boff = lds_byte(wc * 32 + fr, fq * 8);
#define PG8_SA(b, h) (((b) * 2 + (h)) * HTB)
#define PG8_SB(b, h) ((4 + (b) * 2 + (h)) * HTB)
#define PG8_STAGE(bufoff, gbase, voff) do { _Pragma("unroll") for (int _i = 0; _i < 2; ++_i) \
        __builtin_amdgcn_global_load_lds((const unsigned*)((const char*)(gbase) + (voff)[_i]), (PG8_LAS unsigned*)(lds + (bufoff) + ldsw + _i * 8192), 16, 0, 0); } while (0)
#define PG8_LDA(dst, b, h) do { _Pragma("unroll") for (int m = 0; m < 4; ++m) _Pragma("unroll") for (int k = 0; k < 2; ++k) dst[m][k] = *(const PG8_LAS bf16x8*)(lds + PG8_SA(b, h) + aoff + m * 2048 + k * 1024); } while (0)
#define PG8_LDB(dst, b, h) do { _Pragma("unroll") for (int n = 0; n < 2; ++n) _Pragma("unroll") for (int k = 0; k < 2; ++k) dst[n][k] = *(const PG8_LAS bf16x8*)(lds + PG8_SB(b, h) + boff + n * 2048 + k * 1024); } while (0)
#define PG8_MMA(ai, bj, At, Bt) do { __builtin_amdgcn_s_setprio(1); _Pragma("unroll") for (int m = 0; m < 4; ++m) _Pragma("unroll") for (int n = 0; n < 2; ++n) _Pragma("unroll") for (int k = 0; k < 2; ++k) \
        acc[ai][bj][m][n] = __builtin_amdgcn_mfma_f32_16x16x32_bf16(Bt[n][k], At[m][k], acc[ai][bj][m][n], 0, 0, 0); __builtin_amdgcn_s_setprio(0); } while (0)
#define PG8_WAIT_V(n) asm volatile("s_waitcnt vmcnt(" #n ")" ::: "memory")
#define PG8_WAIT_L(n) asm volatile("s_waitcnt lgkmcnt(" #n ")" ::: "memory")
#define PG8_BAR __builtin_amdgcn_s_barrier()
#define PG8_SCHED __builtin_amdgcn_sched_barrier(0)
    Unit cur, nxt; int ui = 0;
    if (!S.next(0, cur)) return;
    f32x4 acc[2][2][4][2];
#pragma unroll
    for (int a = 0; a < 2; ++a)
#pragma unroll
        for (int b = 0; b < 2; ++b)
#pragma unroll
            for (int m = 0; m < 4; ++m)
#pragma unroll
                for (int n = 0; n < 2; ++n) acc[a][b][m][n] = (f32x4){0.f, 0.f, 0.f, 0.f};
    bf16x8 At[4][2], B0[2][2], B1[2][2];
    const char* cA = a_ptr(g, cur.pm, tstep); const char* cB = (const char*)g.Bt + (size_t)cur.pn * tstep;
    S.a_ready(cur);
    if constexpr (SP2) {
        PG8_STAGE(PG8_SB(0, 0), cB, voffB); PG8_STAGE(PG8_SB(0, 1), cB + hstep, voffB); PG8_STAGE(PG8_SA(0, 0), cA, voffA); PG8_STAGE(PG8_SA(0, 1), cA + hstep, voffA);
        if (wr == 1) PG8_BAR;
        PG8_WAIT_V(2); PG8_BAR;
        PG8_STAGE(PG8_SB(1, 0), cB + kstep, voffB); PG8_STAGE(PG8_SA(1, 0), cA + kstep, voffA); PG8_STAGE(PG8_SB(1, 1), cB + hstep + kstep, voffB);
        PG8_WAIT_V(6); PG8_BAR;
    } else {
        PG8_STAGE(PG8_SB(0, 0), cB, voffB); PG8_STAGE(PG8_SA(0, 0), cA, voffA); PG8_STAGE(PG8_SB(0, 1), cB + hstep, voffB); PG8_STAGE(PG8_SA(0, 1), cA + hstep, voffA);
        if (wr == 1) PG8_BAR;
        PG8_WAIT_V(4); PG8_BAR;
        PG8_STAGE(PG8_SB(1, 0), cB + kstep, voffB); PG8_STAGE(PG8_SA(1, 0), cA + kstep, voffA); PG8_STAGE(PG8_SB(1, 1), cB + hstep + kstep, voffB);
        PG8_WAIT_V(6); PG8_BAR;
    }
    for (;;) {
        const bool has_next = S.next(ui + 1, nxt);
        const char* nA = has_next ? a_ptr(g, nxt.pm, tstep) : cA; const char* nB = has_next ? (const char*)g.Bt + (size_t)nxt.pn * tstep : cB;
        for (int t = 0; t < nt; t += 2) {
            const bool last = (t == nt - 2);
            const char* a1 = cA + (size_t)(t + 1) * kstep;
            const char* a2 = last ? nA : cA + (size_t)(t + 2) * kstep; const char* b2 = last ? nB : cB + (size_t)(t + 2) * kstep;
            const char* a3 = a2 + kstep; const char* b3 = b2 + kstep;
            if (last && has_next) S.a_ready(nxt);
            if constexpr (SP2) {
            PG8_LDB(B0, 0, 0); PG8_LDB(B1, 0, 1); PG8_SCHED; PG8_LDA(At, 0, 0); PG8_STAGE(PG8_SA(1, 1), a1 + hstep, voffA);
            PG8_WAIT_V(8); PG8_WAIT_L(0); PG8_BAR; PG8_MMA(0, 0, At, B0); PG8_MMA(0, 1, At, B1); PG8_BAR; PG8_SCHED;
            PG8_LDA(At, 0, 1); PG8_STAGE(PG8_SB(0, 0), b2, voffB); PG8_STAGE(PG8_SB(0, 1), b2 + hstep, voffB); PG8_STAGE(PG8_SA(0, 0), a2, voffA);
            PG8_WAIT_V(8); PG8_WAIT_L(0); PG8_BAR; PG8_MMA(1, 0, At, B0); PG8_MMA(1, 1, At, B1); PG8_BAR; PG8_SCHED;
            PG8_LDB(B0, 1, 0); PG8_LDB(B1, 1, 1); PG8_SCHED; PG8_LDA(At, 1, 0); PG8_STAGE(PG8_SA(0, 1), a2 + hstep, voffA);
            PG8_WAIT_V(8); PG8_WAIT_L(0); PG8_BAR; PG8_MMA(0, 0, At, B0); PG8_MMA(0, 1, At, B1); PG8_BAR; PG8_SCHED;
            PG8_LDA(At, 1, 1); PG8_STAGE(PG8_SB(1, 0), b3, voffB); PG8_STAGE(PG8_SB(1, 1), b3 + hstep, voffB); PG8_STAGE(PG8_SA(1, 0), a3, voffA);
            PG8_WAIT_V(8); PG8_WAIT_L(0); PG8_BAR; PG8_MMA(1, 0, At, B0); PG8_MMA(1, 1, At, B1); PG8_BAR; PG8_SCHED;
            } else {
            PG8_LDB(B0, 0, 0); PG8_SCHED; PG8_LDA(At, 0, 0); PG8_STAGE(PG8_SA(1, 1), a1 + hstep, voffA);
            PG8_WAIT_L(8); PG8_BAR; PG8_WAIT_L(0); PG8_MMA(0, 0, At, B0); PG8_BAR; PG8_SCHED;
            PG8_LDB(B1, 0, 1); PG8_STAGE(PG8_SB(0, 0), b2, voffB);
            PG8_BAR; PG8_WAIT_L(0); PG8_MMA(0, 1, At, B1); PG8_BAR;
            PG8_LDA(At, 0, 1); PG8_STAGE(PG8_SA(0, 0), a2, voffA);
            PG8_BAR; PG8_WAIT_L(0); PG8_MMA(1, 0, At, B0); PG8_BAR; PG8_SCHED;
            PG8_STAGE(PG8_SB(0, 1), b2 + hstep, voffB);
            PG8_WAIT_V(6); PG8_BAR; PG8_MMA(1, 1, At, B1); PG8_BAR;
            PG8_LDB(B0, 1, 0); PG8_SCHED; PG8_LDA(At, 1, 0); PG8_STAGE(PG8_SA(0, 1), a2 + hstep, voffA);
            PG8_WAIT_L(8); PG8_BAR; PG8_WAIT_L(0); PG8_MMA(0, 0, At, B0); PG8_BAR; PG8_SCHED;
            PG8_LDB(B1, 1, 1); PG8_STAGE(PG8_SB(1, 0), b3, voffB);
            PG8_BAR; PG8_WAIT_L(0); PG8_MMA(0, 1, At, B1); PG8_BAR;
            PG8_LDA(At, 1, 1); PG8_STAGE(PG8_SA(1, 0), a3, voffA);
            PG8_BAR; PG8_WAIT_L(0); PG8_MMA(1, 0, At, B0); PG8_BAR; PG8_SCHED;
            PG8_STAGE(PG8_SB(1, 1), b3 + hstep, voffB);
            PG8_WAIT_V(6); PG8_BAR; PG8_MMA(1, 1, At, B1); PG8_BAR;
            }
        }
        if constexpr (ALIGN_EPI) { if (wr == 0) PG8_BAR; }
        if constexpr (!Epi::AFTER_DRAIN) { E(acc, cur, wr, wc, fr, fq); S.done(cur); }
        if (!has_next) break;
#pragma unroll
        for (int a = 0; a < 2; ++a)
#pragma unroll
            for (int b = 0; b < 2; ++b)
#pragma unroll
                for (int m = 0; m < 4; ++m)
#pragma unroll
                    for (int n = 0; n < 2; ++n) acc[a][b][m][n] = (f32x4){0.f, 0.f, 0.f, 0.f};
        cur = nxt; cA = nA; cB = nB; ++ui;
        if constexpr (ALIGN_EPI) { if (wr == 1) PG8_BAR; }
    }
    PG8_WAIT_V(0);
    if constexpr (!ALIGN_EPI) { if (wr == 0) PG8_BAR; }
    PG8_BAR;
    if constexpr (Epi::AFTER_DRAIN) { E.fused(acc, cur, wr, wc, fr, fq, lds, wid, lane); S.done(cur); }
#undef PG8_SA
#undef PG8_SB
#undef PG8_STAGE
#undef PG8_LDA
#undef PG8_LDB
#undef PG8_MMA
#undef PG8_WAIT_V
#undef PG8_WAIT_L
#undef PG8_BAR
#undef PG8_SCHED
}
}

#define LAS __attribute__((address_space(3)))
typedef unsigned short bf16;
typedef float f4 __attribute__((ext_vector_type(4)));
typedef float f2 __attribute__((ext_vector_type(2)));
typedef float f16v __attribute__((ext_vector_type(16)));
typedef short s8 __attribute__((ext_vector_type(8)));
typedef short s4v __attribute__((ext_vector_type(4)));
typedef unsigned u4 __attribute__((ext_vector_type(4)));
typedef unsigned u2 __attribute__((ext_vector_type(2)));

constexpr int NB = 8, T = 8192, D = 1024, M = NB * T, DEPTH = 4;
constexpr int ZE_LD = 3344, ZO_LD = 3072, FF = 2816, NWAVES = 8;
constexpr float LOG2E = 1.4426950408889634f;
constexpr float SCL = 0.125f * LOG2E;
constexpr float RMS_EPS = 1e-6f, GN_EPS = 64e-5f;

constexpr size_t MiB = 1u << 20;
constexpr size_t WS_CTL = 0, WS_WIN = 1 * MiB, WS_WOUT = 8 * MiB, WS_WUP = 10 * MiB, WS_WDN = 21 * MiB, WS_LORA = 27 * MiB, WS_CS = 28 * MiB, WS_C2 = 32 * MiB, WS_ML = 34 * MiB,
                 WS_H = 43 * MiB, WS_Y = 172 * MiB, WS_A = 300 * MiB, WS_Z = 556 * MiB, WS_END = 974 * MiB;
constexpr int LDS_RING = 131072, LDS_X = 131072, LDS_MISC = 147456, LDS_BYTES = 148480;

__device__ __forceinline__ unsigned pk2(float lo, float hi) { return pg8::cvt_pk_bf16(lo, hi); }
__device__ __forceinline__ float bf2f(unsigned short b) { return __builtin_bit_cast(float, (unsigned)b << 16); }
__device__ __forceinline__ float bflo(unsigned w) { return __builtin_bit_cast(float, w << 16); }
__device__ __forceinline__ float bfhi(unsigned w) { return __builtin_bit_cast(float, w & 0xffff0000u); }
template <int CTRL> __device__ __forceinline__ float dpp(float x) { return pg8::dppf<CTRL>(x); }
__device__ __forceinline__ float red16(float v) { v += dpp<0xB1>(v); v += dpp<0x4E>(v); v += dpp<0x141>(v); v += dpp<0x128>(v); return v; }
__device__ __forceinline__ float wave_sum(float v) {
#pragma unroll
    for (int o = 1; o < 64; o <<= 1) v += __shfl_xor(v, o);
    return v;
}
__device__ __forceinline__ float swap32_max(float m) { float a = m, b = m; asm volatile("s_nop 1\n\tv_permlane32_swap_b32 %0, %1\n\ts_nop 1" : "+v"(a), "+v"(b)); return fmaxf(a, b); }
__device__ __forceinline__ float swap32_sum(float m) { float a = m, b = m; asm volatile("s_nop 1\n\tv_permlane32_swap_b32 %0, %1\n\ts_nop 1" : "+v"(a), "+v"(b)); return a + b; }
__device__ __forceinline__ float fast_exp(float x) { return __builtin_amdgcn_exp2f(x * LOG2E); }
__device__ __forceinline__ float fast_sigmoid(float x) { return __builtin_amdgcn_rcpf(1.0f + fast_exp(-x)); }
__device__ __forceinline__ float fast_tanh(float x) { return 1.0f - 2.0f * __builtin_amdgcn_rcpf(1.0f + fast_exp(2.0f * x)); }
__device__ __forceinline__ float log1p_small(float e) { return e < 0.01f ? e * (1.0f - e * (0.5f - e * (1.0f / 3.0f))) : __logf(1.0f + e); }
__device__ __forceinline__ float softplusf(float y) { return fmaxf(y, 0.f) + log1p_small(fast_exp(-fabsf(y))); }
__device__ __forceinline__ int crow(int r, int hi) { return (r & 3) + 8 * (r >> 2) + 4 * hi; }
__device__ __forceinline__ s4v vtr(const LAS unsigned char* p) { return __builtin_bit_cast(s4v, __builtin_amdgcn_ds_read_tr16_b64_v4i16((LAS s4v*)p)); }

struct Args {
    const float* in[26]; float* out; unsigned char* ws; float inv_freq[8];
};

struct MapId { int n; __device__ __forceinline__ int operator()(int r) const { return r < n ? r : -1; } };
struct MapEvenIn { __device__ __forceinline__ int operator()(int r) const { return r < 1536 ? r : (r < 3328 ? r + 8 : (r < 3336 ? 1536 + (r - 3328) : -1)); } };
struct MapOddIn { __device__ __forceinline__ int operator()(int r) const { if (r >= 2048) return r; const int p = r & 63; return p < 16 ? (r & ~63) + (p >> 1) + 8 * (p & 1) : r; } };
struct MapUp { __device__ __forceinline__ int operator()(int r) const { const int pn = r >> 8, bj = (r >> 7) & 1, c = r & 127; return bj * 2816 + pn * 128 + c; } };
template <class Map> __device__ __forceinline__ void tr_convert(const float* W, int K, int N, bf16* WT, int Nout, const Map src, LAS float* scr, int gw, int NGW, int lane) {
    const int nblk = Nout / 32, items = (K / 64) * nblk;
    for (int it = gw; it < items; it += NGW) {
        const int kb = it / nblk, nb = it % nblk, k0 = 64 * kb, n0 = 32 * nb;
        const int sc = src(n0 + (lane & 31));
#pragma unroll 8
        for (int i = 0; i < 32; ++i) { const int kk = 2 * i + (lane >> 5); scr[kk * 33 + (lane & 31)] = sc >= 0 ? __builtin_nontemporal_load(W + (size_t)(k0 + kk) * N + sc) : 0.f; }
        asm volatile("s_waitcnt lgkmcnt(0)" ::: "memory");
        const int c = lane & 7;
#pragma unroll
        for (int j = 0; j < 4; ++j) { const int n = (lane >> 3) + 8 * j; const LAS float* s = scr + (8 * c) * 33 + n;
            u4 o; o.x = pk2(s[0 * 33], s[1 * 33]); o.y = pk2(s[2 * 33], s[3 * 33]); o.z = pk2(s[4 * 33], s[5 * 33]); o.w = pk2(s[6 * 33], s[7 * 33]);
            *(u4*)(WT + (size_t)(n0 + n) * K + k0 + 8 * c) = o; }
        asm volatile("s_waitcnt lgkmcnt(0)" ::: "memory");
    }
}
template <class AT> __device__ __forceinline__ void convert_layer_weights(const AT& A, int layer, LAS unsigned char* lds, int gw, int NGW, int wave, int lane) {
    LAS float* scr = (LAS float*)(lds + wave * 16384);
    unsigned char* ws = A.ws; const int i = layer >> 1;
    if ((layer & 1) == 0) {
        tr_convert(A.in[6] + (size_t)i * 1024 * 3336, 1024, 3336, (bf16*)(ws + WS_WIN), 3584, MapEvenIn{}, scr, gw, NGW, lane);
        tr_convert(A.in[19] + (size_t)i * 1024 * 1024, 1024, 1024, (bf16*)(ws + WS_WOUT), 1024, MapId{1024}, scr, gw, NGW, lane);
        tr_convert(A.in[10] + (size_t)i * 64 * 512, 64, 512, (bf16*)(ws + WS_LORA), 512, MapId{512}, scr, gw, NGW, lane);
        tr_convert(A.in[12] + (size_t)i * 64 * 512, 64, 512, (bf16*)(ws + WS_LORA + 65536), 512, MapId{512}, scr, gw, NGW, lane);
        tr_convert(A.in[13] + (size_t)i * 128 * 512, 128, 512, (bf16*)(ws + WS_LORA + 131072), 512, MapId{512}, scr, gw, NGW, lane);
    } else {
        tr_convert(A.in[20] + (size_t)i * 1024 * 3072, 1024, 3072, (bf16*)(ws + WS_WIN), 3072, MapOddIn{}, scr, gw, NGW, lane);
        tr_convert(A.in[21] + (size_t)i * 1024 * 1024, 1024, 1024, (bf16*)(ws + WS_WOUT), 1024, MapId{1024}, scr, gw, NGW, lane);
    }
    tr_convert(A.in[22] + (size_t)layer * 1024 * 5632, 1024, 5632, (bf16*)(ws + WS_WUP), 5632, MapUp{}, scr, gw, NGW, lane);
    tr_convert(A.in[25] + (size_t)layer * 2816 * 1024, 2816, 1024, (bf16*)(ws + WS_WDN), 1024, MapId{1024}, scr, gw, NGW, lane);
}

__device__ __forceinline__ void row_phase(const float* xsrc, const bf16* mbuf, const float* gpost, float* xout, const float* gpre, bf16* hout, int gw, int NGW, int lane) {
    f4 gp[4], gq[4];
#pragma unroll
    for (int j = 0; j < 4; ++j) { gp[j] = mbuf ? *(const f4*)(gpost + 4 * lane + 256 * j) : (f4){0.f, 0.f, 0.f, 0.f}; gq[j] = hout ? *(const f4*)(gpre + 4 * lane + 256 * j) : (f4){0.f, 0.f, 0.f, 0.f}; }
    for (int row = gw; row < M; row += NGW) {
        f4 x[4];
#pragma unroll
        for (int j = 0; j < 4; ++j) x[j] = __builtin_nontemporal_load((const f4*)(xsrc + (size_t)row * D + 4 * lane + 256 * j));
        if (mbuf) {
            f4 mv[4]; float ss = 0.f;
#pragma unroll
            for (int j = 0; j < 4; ++j) { const u2 mw = __builtin_nontemporal_load((const u2*)(mbuf + (size_t)row * D + 4 * lane + 256 * j)); mv[j] = (f4){bflo(mw.x), bfhi(mw.x), bflo(mw.y), bfhi(mw.y)}; ss += (mv[j].x * mv[j].x + mv[j].y * mv[j].y) + (mv[j].z * mv[j].z + mv[j].w * mv[j].w); }
            const float rs = __builtin_amdgcn_rsqf(wave_sum(ss) * (1.0f / D) + RMS_EPS);
#pragma unroll
            for (int j = 0; j < 4; ++j) x[j] = x[j] + mv[j] * rs * gp[j];
        }
        if (xout) {
#pragma unroll
            for (int j = 0; j < 4; ++j) __builtin_nontemporal_store(x[j], (f4*)(xout + (size_t)row * D + 4 * lane + 256 * j));
        }
        if (hout) {
            float ss = 0.f;
#pragma unroll
            for (int j = 0; j < 4; ++j) ss += (x[j].x * x[j].x + x[j].y * x[j].y) + (x[j].z * x[j].z + x[j].w * x[j].w);
            const float rs = __builtin_amdgcn_rsqf(wave_sum(ss) * (1.0f / D) + RMS_EPS);
#pragma unroll
            for (int j = 0; j < 4; ++j) { const f4 o = x[j] * rs * gq[j]; u2 w; w.x = pk2(o.x, o.y); w.y = pk2(o.z, o.w); *(u2*)(hout + (size_t)row * D + 4 * lane + 256 * j) = w; }
        }
    }
}

struct AttnP {
    const bf16 *q, *k, *v; int ld;
    int stride, resid;
    int qi0, kbase, jt0, jt1, W;
    float kmax;
    const float* c2;
    bf16* oacc; float* ml;
    int load_state, final;
    bf16* y;
};
constexpr int ATT_BUFB = 43520;
template <bool FOX> __device__ __forceinline__ void attn_unit(const AttnP& P, LAS unsigned char* lds, int tid, int wave, int lane) {
    __syncthreads();
    const int r32 = lane & 31, hi = lane >> 5;
    const int wq0 = P.qi0 + wave * 32, iq = wq0 + r32;
    const long qtok = (long)iq * P.stride + P.resid;
    s8 qf[4];
#pragma unroll
    for (int ds = 0; ds < 4; ++ds) qf[ds] = __builtin_nontemporal_load((const s8*)(P.q + qtok * P.ld + ds * 16 + hi * 8));
    float cq2 = 0.f; if (FOX) cq2 = P.c2[qtok * 8];
    float qbound = 0.f;
    if (FOX) { float qs = 0.f;
#pragma unroll
        for (int ds = 0; ds < 4; ++ds) { const u4 w = __builtin_bit_cast(u4, qf[ds]); const unsigned ww[4] = {w.x, w.y, w.z, w.w};
#pragma unroll
            for (int k = 0; k < 4; ++k) { const float lo = bflo(ww[k]), hh = bfhi(ww[k]); qs += lo * lo + hh * hh; } }
        qs = swap32_sum(qs); qbound = sqrtf(qs) * SCL * P.kmax * 1.001f + 1.0f; }
    LAS int* cntw = (LAS int*)(lds + LDS_MISC + 256);
    if (FOX && tid < 64) cntw[tid] = 0;
    bool wdone = false, first = true; float cbase = cq2;
    f16v o0, o1; float mrun = FOX ? 0.f : -1e30f, lsum = 0.f;
#pragma unroll
    for (int r = 0; r < 16; ++r) { o0[r] = 0.f; o1[r] = 0.f; }
    if (P.load_state) {
        const bf16* op = P.oacc + qtok * 1024 + 4 * hi;
#pragma unroll
        for (int rg = 0; rg < 4; ++rg) { const u2 aw = *(const u2*)(op + 8 * rg), bw = *(const u2*)(op + 32 + 8 * rg);
            o0[4 * rg] = bflo(aw.x); o0[4 * rg + 1] = bfhi(aw.x); o0[4 * rg + 2] = bflo(aw.y); o0[4 * rg + 3] = bfhi(aw.y);
            o1[4 * rg] = bflo(bw.x); o1[4 * rg + 1] = bfhi(bw.x); o1[4 * rg + 2] = bflo(bw.y); o1[4 * rg + 3] = bfhi(bw.y); }
        mrun = P.ml[qtok * 32]; lsum = (hi == 0) ? P.ml[qtok * 32 + 1] : 0.f;
    }
    int jlo = (wq0 - P.W - P.kbase) >> 6; if (jlo < P.jt0) jlo = P.jt0;
    int jhi = (wq0 + 31 - P.kbase) >> 6; if (jhi > P.jt1 - 1) jhi = P.jt1 - 1;
    const int lrow = tid >> 3, lch = tid & 7;
    u4 kreg0, vreg0, kreg1, vreg1; float creg = 0.f;
#define ATT_LOAD(jd) do { const long ktok_ = (long)(P.kbase + 128 * (jd) + lrow) * P.stride + P.resid; const long kstep_ = 64L * P.stride * P.ld; \
        const bf16* kp_ = P.k + ktok_ * P.ld + lch * 8; const bf16* vp_ = P.v + ktok_ * P.ld + lch * 8; \
        kreg0 = *(const u4*)kp_; vreg0 = *(const u4*)vp_; kreg1 = *(const u4*)(kp_ + kstep_); vreg1 = *(const u4*)(vp_ + kstep_); \
        if (FOX && tid < 128) { const long ct_ = (long)(P.kbase + 128 * (jd) + tid) * P.stride + P.resid; creg = P.c2[ct_ * 8]; } } while (0)
#define ATT_STORE(bb) do { LAS unsigned char* b_ = lds + (bb) * ATT_BUFB; \
        *(LAS u4*)(b_ + lrow * 144 + lch * 16) = kreg0; *(LAS u4*)(b_ + (lrow + 64) * 144 + lch * 16) = kreg1; \
        *(LAS u4*)(b_ + 18432 + lrow * 192 + lch * 16) = vreg0; *(LAS u4*)(b_ + 18432 + (lrow + 64) * 192 + lch * 16) = vreg1; \
        if (FOX && tid < 128) *(LAS float*)(b_ + 43008 + tid * 4) = creg; } while (0)
    const int jd0 = P.jt0 >> 1, jd1 = P.jt1 >> 1;
    const int jdir = FOX ? -1 : 1, jfirst = FOX ? jd1 - 1 : jd0, nj = jd1 - jd0;
    ATT_LOAD(jfirst); ATT_STORE(0); __syncthreads();
    const int g16 = lane >> 4, i16 = lane & 15;
    const int vlane_off = (4 * hi + (i16 >> 2)) * 192 + (16 * (g16 & 1) + 4 * (i16 & 3)) * 2;
    for (int ji = 0; ji < nj; ++ji) {
        const int jd = jfirst + jdir * ji;
        const int bsel = ji & 1;
        if (ji + 1 < nj) ATT_LOAD(jd + jdir);
        if constexpr (FOX) {
        if (2 * jd <= jhi) {
            const LAS unsigned char* Kb = lds + bsel * ATT_BUFB; const LAS unsigned char* Vb = lds + bsel * ATT_BUFB + 18432;
            const LAS float* ckb = (const LAS float*)(lds + bsel * ATT_BUFB + 43008);
            f16v sc[4];
#pragma unroll
            for (int t4 = 0; t4 < 4; ++t4)
#pragma unroll
                for (int r = 0; r < 16; ++r) sc[t4][r] = 0.f;
#pragma unroll
            for (int ds = 0; ds < 4; ++ds)
#pragma unroll
                for (int t4 = 0; t4 < 4; ++t4) {
                    const s8 kf = *(const LAS s8*)(Kb + (32 * t4 + r32) * 144 + (ds * 16 + hi * 8) * 2);
                    sc[t4] = __builtin_amdgcn_mfma_f32_32x32x16_bf16(kf, qf[ds], sc[t4], 0, 0, 0);
                }
            const int kv0 = P.kbase + 128 * jd;
            const bool need_mask = (kv0 + 127 > wq0);
#pragma unroll
            for (int t4 = 0; t4 < 4; ++t4)
#pragma unroll
                for (int rg = 0; rg < 4; ++rg) {
                    const f4 c0 = *(const LAS f4*)(ckb + 32 * t4 + 8 * rg + 4 * hi);
#pragma unroll
                    for (int j = 0; j < 4; ++j) { const int r = 4 * rg + j;
                        float x0 = sc[t4][r] * SCL + (cbase - c0[j]);
                        if (need_mask) { const int kj = kv0 + 32 * t4 + crow(r, hi); if (kj > iq) x0 = -1e30f; }
                        sc[t4][r] = x0; }
                }
            float mx = fmaxf(fmaxf(sc[0][0], sc[1][0]), fmaxf(sc[2][0], sc[3][0]));
#pragma unroll
            for (int r = 1; r < 16; ++r) mx = fmaxf(mx, fmaxf(fmaxf(sc[0][r], sc[1][r]), fmaxf(sc[2][r], sc[3][r])));
            mx = swap32_max(mx);
            if (__any(first || mx > -160.0f)) {
            const float delta = (first || mx > 8.0f) ? mx : 0.f;
            if (__any(delta != 0.f)) {
                const float alpha = first ? 0.f : __builtin_amdgcn_exp2f(-delta);
                lsum *= alpha;
#pragma unroll
                for (int r = 0; r < 16; ++r) { o0[r] *= alpha; o1[r] *= alpha; }
#pragma unroll
                for (int t4 = 0; t4 < 4; ++t4)
#pragma unroll
                    for (int r = 0; r < 16; ++r) sc[t4][r] -= delta;
                mrun += delta; cbase -= delta;
            }
            first = false;
            float ps = 0.f;
#pragma unroll
            for (int t4 = 0; t4 < 4; ++t4)
#pragma unroll
                for (int r = 0; r < 16; ++r) { sc[t4][r] = __builtin_amdgcn_exp2f(sc[t4][r]); ps += sc[t4][r]; }
            lsum += ps;
#pragma unroll
            for (int t4 = 0; t4 < 4; ++t4)
#pragma unroll
                for (int s = 0; s < 2; ++s) {
                    const u4 pw = (u4){pk2(sc[t4][8 * s + 0], sc[t4][8 * s + 1]), pk2(sc[t4][8 * s + 2], sc[t4][8 * s + 3]), pk2(sc[t4][8 * s + 4], sc[t4][8 * s + 5]), pk2(sc[t4][8 * s + 6], sc[t4][8 * s + 7])};
                    const LAS unsigned char* vp = Vb + (32 * t4 + 16 * s) * 192 + vlane_off;
                    const s4v a0 = vtr(vp), a1 = vtr(vp + 8 * 192), b0 = vtr(vp + 64), b1 = vtr(vp + 8 * 192 + 64);
                    const s8 vf0 = (s8){a0[0], a0[1], a0[2], a0[3], a1[0], a1[1], a1[2], a1[3]};
                    const s8 vf1 = (s8){b0[0], b0[1], b0[2], b0[3], b1[0], b1[1], b1[2], b1[3]};
                    const s8 pb = __builtin_bit_cast(s8, pw);
                    o0 = __builtin_amdgcn_mfma_f32_32x32x16_bf16(vf0, pb, o0, 0, 0, 0);
                    o1 = __builtin_amdgcn_mfma_f32_32x32x16_bf16(vf1, pb, o1, 0, 0, 0);
                }
            }
            if (!wdone && __all((qbound + (cbase - ckb[0]) < -160.0f) && !first)) wdone = true;
        }
        if (wdone && lane == 0) atomicAdd((int*)&cntw[ji], 1);
        } else {
#pragma unroll
        for (int sub = 0; sub < 2; ++sub) {
        const int jt = 2 * jd + sub;
        if (jt >= jlo && jt <= jhi) {
            const LAS unsigned char* Kb = lds + bsel * ATT_BUFB + sub * (64 * 144); const LAS unsigned char* Vb = lds + bsel * ATT_BUFB + 18432 + sub * (64 * 192);
            const LAS float* ckb = (const LAS float*)(lds + bsel * ATT_BUFB + 43008) + sub * 64;
            f16v s0, s1;
#pragma unroll
            for (int r = 0; r < 16; ++r) { s0[r] = 0.f; s1[r] = 0.f; }
#pragma unroll
            for (int ds = 0; ds < 4; ++ds) {
                const s8 k0 = *(const LAS s8*)(Kb + r32 * 144 + (ds * 16 + hi * 8) * 2);
                const s8 k1 = *(const LAS s8*)(Kb + (32 + r32) * 144 + (ds * 16 + hi * 8) * 2);
                s0 = __builtin_amdgcn_mfma_f32_32x32x16_bf16(k0, qf[ds], s0, 0, 0, 0);
                s1 = __builtin_amdgcn_mfma_f32_32x32x16_bf16(k1, qf[ds], s1, 0, 0, 0);
            }
            const int kv0 = P.kbase + 64 * jt;
            const bool need_mask = (kv0 + 63 > wq0) || (kv0 < wq0 + 31 - P.W);
#pragma unroll
            for (int rg = 0; rg < 4; ++rg) {
                f4 c0 = (f4){0.f, 0.f, 0.f, 0.f}, c1 = c0;
                if (FOX) { c0 = *(const LAS f4*)(ckb + 8 * rg + 4 * hi); c1 = *(const LAS f4*)(ckb + 32 + 8 * rg + 4 * hi); }
#pragma unroll
                for (int j = 0; j < 4; ++j) { const int r = 4 * rg + j;
                    float x0 = s0[r] * SCL, x1 = s1[r] * SCL;
                    if (FOX) { x0 += cq2 - c0[j]; x1 += cq2 - c1[j]; }
                    if (need_mask) { const int kj = kv0 + crow(r, hi); if (kj > iq || kj < iq - P.W) x0 = -1e30f; if (kj + 32 > iq || kj + 32 < iq - P.W) x1 = -1e30f; }
                    s0[r] = x0; s1[r] = x1; }
            }
            float mx = fmaxf(s0[0], s1[0]);
#pragma unroll
            for (int r = 1; r < 16; ++r) mx = fmaxf(mx, fmaxf(s0[r], s1[r]));
            mx = swap32_max(mx);
            const float mnew = (mx > mrun + 8.0f) ? mx : mrun;
            if (__any(mnew != mrun)) {
                const float alpha = __builtin_amdgcn_exp2f(mrun - mnew);
                lsum *= alpha;
#pragma unroll
                for (int r = 0; r < 16; ++r) { o0[r] *= alpha; o1[r] *= alpha; }
            }
            mrun = mnew;
            float ps = 0.f;
#pragma unroll
            for (int r = 0; r < 16; ++r) { s0[r] = __builtin_amdgcn_exp2f(s0[r] - mnew); s1[r] = __builtin_amdgcn_exp2f(s1[r] - mnew); ps += s0[r] + s1[r]; }
            lsum += ps;
            u4 pf[2][2];
#pragma unroll
            for (int s = 0; s < 2; ++s) {
                pf[0][s] = (u4){pk2(s0[8 * s + 0], s0[8 * s + 1]), pk2(s0[8 * s + 2], s0[8 * s + 3]), pk2(s0[8 * s + 4], s0[8 * s + 5]), pk2(s0[8 * s + 6], s0[8 * s + 7])};
                pf[1][s] = (u4){pk2(s1[8 * s + 0], s1[8 * s + 1]), pk2(s1[8 * s + 2], s1[8 * s + 3]), pk2(s1[8 * s + 4], s1[8 * s + 5]), pk2(s1[8 * s + 6], s1[8 * s + 7])};
            }
#pragma unroll
            for (int kt = 0; kt < 2; ++kt)
#pragma unroll
                for (int s = 0; s < 2; ++s) {
                    const LAS unsigned char* vp = Vb + (32 * kt + 16 * s) * 192 + vlane_off;
                    const s4v a0 = vtr(vp), a1 = vtr(vp + 8 * 192), b0 = vtr(vp + 64), b1 = vtr(vp + 8 * 192 + 64);
                    const s8 vf0 = (s8){a0[0], a0[1], a0[2], a0[3], a1[0], a1[1], a1[2], a1[3]};
                    const s8 vf1 = (s8){b0[0], b0[1], b0[2], b0[3], b1[0], b1[1], b1[2], b1[3]};
                    const s8 pb = __builtin_bit_cast(s8, pf[kt][s]);
                    o0 = __builtin_amdgcn_mfma_f32_32x32x16_bf16(vf0, pb, o0, 0, 0, 0);
                    o1 = __builtin_amdgcn_mfma_f32_32x32x16_bf16(vf1, pb, o1, 0, 0, 0);
                }
        }
        }
        }
        if (ji + 1 < nj) ATT_STORE(bsel ^ 1);
        __syncthreads();
        if (FOX) { if (cntw[ji] == NWAVES) break; }
    }
#undef ATT_LOAD
#undef ATT_STORE
    const float ltot = swap32_sum(lsum);
    if (!P.final) {
        bf16* op = P.oacc + qtok * 1024 + 4 * hi;
#pragma unroll
        for (int rg = 0; rg < 4; ++rg) { u2 aw, bw; aw.x = pk2(o0[4 * rg], o0[4 * rg + 1]); aw.y = pk2(o0[4 * rg + 2], o0[4 * rg + 3]); bw.x = pk2(o1[4 * rg], o1[4 * rg + 1]); bw.y = pk2(o1[4 * rg + 2], o1[4 * rg + 3]);
            *(u2*)(op + 8 * rg) = aw; *(u2*)(op + 32 + 8 * rg) = bw; }
        if (hi == 0) { P.ml[qtok * 32] = mrun; P.ml[qtok * 32 + 1] = ltot; }
    } else {
        const float inv = 1.0f / ltot;
        bf16* yp = P.y + qtok * 1024 + 4 * hi;
#pragma unroll
        for (int rg = 0; rg < 4; ++rg) {
            u2 w0, w1; w0.x = pk2(o0[4 * rg] * inv, o0[4 * rg + 1] * inv); w0.y = pk2(o0[4 * rg + 2] * inv, o0[4 * rg + 3] * inv);
            w1.x = pk2(o1[4 * rg] * inv, o1[4 * rg + 1] * inv); w1.y = pk2(o1[4 * rg + 2] * inv, o1[4 * rg + 3] * inv);
            *(u2*)(yp + 8 * rg) = w0; *(u2*)(yp + 32 + 8 * rg) = w1;
        }
    }
}

__device__ __forceinline__ void attn_band_unit(const AttnP& P, LAS unsigned char* lds, int tid, int wave, int lane) {
    __syncthreads();
    const int r32 = lane & 31, hi = lane >> 5;
    const int wq0 = P.qi0 + wave * 32, iq = wq0 + r32;
    const long qtok = (long)iq * P.stride + P.resid;
    s8 qf[4];
#pragma unroll
    for (int ds = 0; ds < 4; ++ds) qf[ds] = __builtin_nontemporal_load((const s8*)(P.q + qtok * P.ld + ds * 16 + hi * 8));
    f16v o0, o1; float mrun = -1e30f, lsum = 0.f;
#pragma unroll
    for (int r = 0; r < 16; ++r) { o0[r] = 0.f; o1[r] = 0.f; }
    if (P.load_state) {
        const bf16* op = P.oacc + qtok * 1024 + 4 * hi;
#pragma unroll
        for (int rg = 0; rg < 4; ++rg) { const u2 aw = *(const u2*)(op + 8 * rg), bw = *(const u2*)(op + 32 + 8 * rg);
            o0[4 * rg] = bflo(aw.x); o0[4 * rg + 1] = bfhi(aw.x); o0[4 * rg + 2] = bflo(aw.y); o0[4 * rg + 3] = bfhi(aw.y);
            o1[4 * rg] = bflo(bw.x); o1[4 * rg + 1] = bfhi(bw.x); o1[4 * rg + 2] = bflo(bw.y); o1[4 * rg + 3] = bfhi(bw.y); }
        mrun = P.ml[qtok * 32]; lsum = (hi == 0) ? P.ml[qtok * 32 + 1] : 0.f;
    }
    int jlo = (wq0 - P.W - P.kbase) >> 6; if (jlo < P.jt0) jlo = P.jt0;
    int jhi = (wq0 + 31 - P.kbase) >> 6; if (jhi > P.jt1 - 1) jhi = P.jt1 - 1;
    {
        const int lrow = tid >> 3, lch = tid & 7;
#pragma unroll
        for (int hf = 0; hf < 2; ++hf) {
            u4 kr[3], vr[3];
#pragma unroll
            for (int q = 0; q < 3; ++q) { int kidx = P.kbase + lrow + 64 * (3 * hf + q); if (kidx < 0) kidx = 0; const long ktok = (long)kidx * P.stride + P.resid;
                kr[q] = *(const u4*)(P.k + ktok * P.ld + lch * 8); vr[q] = *(const u4*)(P.v + ktok * P.ld + lch * 8); }
#pragma unroll
            for (int q = 0; q < 3; ++q) { const int row = lrow + 64 * (3 * hf + q);
                *(LAS u4*)(lds + row * 144 + lch * 16) = kr[q]; *(LAS u4*)(lds + 55296 + row * 192 + lch * 16) = vr[q]; }
        }
    }
    __syncthreads();
    const int g16 = lane >> 4, i16 = lane & 15;
    const int vlane_off = (4 * hi + (i16 >> 2)) * 192 + (16 * (g16 & 1) + 4 * (i16 & 3)) * 2;
#pragma unroll 1
    for (int jt = jlo; jt <= jhi; ++jt) {
        {
            const LAS unsigned char* Kb = lds + jt * (64 * 144); const LAS unsigned char* Vb = lds + 55296 + jt * (64 * 192);
            f16v s0, s1;
#pragma unroll
            for (int r = 0; r < 16; ++r) { s0[r] = 0.f; s1[r] = 0.f; }
#pragma unroll
            for (int ds = 0; ds < 4; ++ds) {
                const s8 k0 = *(const LAS s8*)(Kb + r32 * 144 + (ds * 16 + hi * 8) * 2);
                const s8 k1 = *(const LAS s8*)(Kb + (32 + r32) * 144 + (ds * 16 + hi * 8) * 2);
                s0 = __builtin_amdgcn_mfma_f32_32x32x16_bf16(k0, qf[ds], s0, 0, 0, 0);
                s1 = __builtin_amdgcn_mfma_f32_32x32x16_bf16(k1, qf[ds], s1, 0, 0, 0);
            }
            const int kv0 = P.kbase + 64 * jt;
            const bool need_mask = (kv0 + 63 > wq0) || (kv0 < wq0 + 31 - P.W);
#pragma unroll
            for (int rg = 0; rg < 4; ++rg) {
#pragma unroll
                for (int j = 0; j < 4; ++j) { const int r = 4 * rg + j;
                    float x0 = s0[r] * SCL, x1 = s1[r] * SCL;
                    if (need_mask) { const int kj = kv0 + crow(r, hi); if (kj > iq || kj < iq - P.W) x0 = -1e30f; if (kj + 32 > iq || kj + 32 < iq - P.W) x1 = -1e30f; }
                    s0[r] = x0; s1[r] = x1; }
            }
            float mx = fmaxf(s0[0], s1[0]);
#pragma unroll
            for (int r = 1; r < 16; ++r) mx = fmaxf(mx, fmaxf(s0[r], s1[r]));
            mx = swap32_max(mx);
            const float mnew = (mx > mrun + 8.0f) ? mx : mrun;
            if (__any(mnew != mrun)) {
                const float alpha = __builtin_amdgcn_exp2f(mrun - mnew);
                lsum *= alpha;
#pragma unroll
                for (int r = 0; r < 16; ++r) { o0[r] *= alpha; o1[r] *= alpha; }
            }
            mrun = mnew;
            float ps = 0.f;
#pragma unroll
            for (int r = 0; r < 16; ++r) { s0[r] = __builtin_amdgcn_exp2f(s0[r] - mnew); s1[r] = __builtin_amdgcn_exp2f(s1[r] - mnew); ps += s0[r] + s1[r]; }
            lsum += ps;
            u4 pf[2][2];
#pragma unroll
            for (int s = 0; s < 2; ++s) {
                pf[0][s] = (u4){pk2(s0[8 * s + 0], s0[8 * s + 1]), pk2(s0[8 * s + 2], s0[8 * s + 3]), pk2(s0[8 * s + 4], s0[8 * s + 5]), pk2(s0[8 * s + 6], s0[8 * s + 7])};
                pf[1][s] = (u4){pk2(s1[8 * s + 0], s1[8 * s + 1]), pk2(s1[8 * s + 2], s1[8 * s + 3]), pk2(s1[8 * s + 4], s1[8 * s + 5]), pk2(s1[8 * s + 6], s1[8 * s + 7])};
            }
#pragma unroll
            for (int kt = 0; kt < 2; ++kt)
#pragma unroll
                for (int s = 0; s < 2; ++s) {
                    const LAS unsigned char* vp = Vb + (32 * kt + 16 * s) * 192 + vlane_off;
                    const s4v a0 = vtr(vp), a1 = vtr(vp + 8 * 192), b0 = vtr(vp + 64), b1 = vtr(vp + 8 * 192 + 64);
                    const s8 vf0 = (s8){a0[0], a0[1], a0[2], a0[3], a1[0], a1[1], a1[2], a1[3]};
                    const s8 vf1 = (s8){b0[0], b0[1], b0[2], b0[3], b1[0], b1[1], b1[2], b1[3]};
                    const s8 pb = __builtin_bit_cast(s8, pf[kt][s]);
                    o0 = __builtin_amdgcn_mfma_f32_32x32x16_bf16(vf0, pb, o0, 0, 0, 0);
                    o1 = __builtin_amdgcn_mfma_f32_32x32x16_bf16(vf1, pb, o1, 0, 0, 0);
                }
        }
    }
    const float ltot = swap32_sum(lsum);
    if (!P.final) {
        bf16* op = P.oacc + qtok * 1024 + 4 * hi;
#pragma unroll
        for (int rg = 0; rg < 4; ++rg) { u2 aw, bw; aw.x = pk2(o0[4 * rg], o0[4 * rg + 1]); aw.y = pk2(o0[4 * rg + 2], o0[4 * rg + 3]); bw.x = pk2(o1[4 * rg], o1[4 * rg + 1]); bw.y = pk2(o1[4 * rg + 2], o1[4 * rg + 3]);
            *(u2*)(op + 8 * rg) = aw; *(u2*)(op + 32 + 8 * rg) = bw; }
        if (hi == 0) { P.ml[qtok * 32] = mrun; P.ml[qtok * 32 + 1] = ltot; }
    } else {
        const float inv = 1.0f / ltot;
        bf16* yp = P.y + qtok * 1024 + 4 * hi;
#pragma unroll
        for (int rg = 0; rg < 4; ++rg) {
            u2 w0, w1; w0.x = pk2(o0[4 * rg] * inv, o0[4 * rg + 1] * inv); w0.y = pk2(o0[4 * rg + 2] * inv, o0[4 * rg + 3] * inv);
            w1.x = pk2(o1[4 * rg] * inv, o1[4 * rg + 1] * inv); w1.y = pk2(o1[4 * rg + 2] * inv, o1[4 * rg + 3] * inv);
            *(u2*)(yp + 8 * rg) = w0; *(u2*)(yp + 32 + 8 * rg) = w1;
        }
    }
}

__device__ __forceinline__ void fox_kmax(unsigned char* ws, int i, int gw, int NGW, int lane) {
    const bf16* z = (const bf16*)(ws + WS_Z);
    const int r32 = lane & 31, hi = lane >> 5;
    for (int job = gw; job < M / 32; job += NGW) {
        const int tok0 = 32 * job; const bf16* zr = z + (size_t)(tok0 + r32) * ZE_LD;
        unsigned* kmax2 = (unsigned*)(ws + WS_CTL) + 256 + 64 * i + (tok0 >> 13) * 8;
#pragma unroll 1
        for (int hh = 0; hh < 4; ++hh) { const int h = 4 * hi + hh; float s = 0.f;
#pragma unroll
            for (int q = 0; q < 8; ++q) { const u4 w = *(const u4*)(zr + 512 + 64 * h + 8 * q); const unsigned ww[4] = {w.x, w.y, w.z, w.w};
#pragma unroll
                for (int k = 0; k < 4; ++k) { const float lo = bflo(ww[k]), hv = bfhi(ww[k]); s += lo * lo + hv * hv; } }
            s = fmaxf(s, dpp<0xB1>(s)); s = fmaxf(s, dpp<0x4E>(s)); s = fmaxf(s, dpp<0x141>(s)); s = fmaxf(s, dpp<0x128>(s));
            if ((lane & 15) == 0) atomicMax(kmax2 + h, __builtin_bit_cast(unsigned, s)); }
    }
}
__device__ __forceinline__ s8 lerp8(const bf16* cur, const bf16* prev, bool has_prev, const float* mu, int act) {
    const u4 c = *(const u4*)cur; u4 p = (u4){0u, 0u, 0u, 0u}; if (has_prev) p = *(const u4*)prev;
    const f4 m0 = *(const f4*)mu, m1 = *(const f4*)(mu + 4);
    float x[8];
    const unsigned cw[4] = {c.x, c.y, c.z, c.w}, pw[4] = {p.x, p.y, p.z, p.w};
#pragma unroll
    for (int i = 0; i < 4; ++i) { const float a = bflo(cw[i]), b = bfhi(cw[i]), pa = bflo(pw[i]), pb = bfhi(pw[i]);
        const float ma = (i < 2) ? m0[2 * i] : m1[2 * i - 4], mb = (i < 2) ? m0[2 * i + 1] : m1[2 * i - 3];
        x[2 * i] = a + (pa - a) * ma; x[2 * i + 1] = b + (pb - b) * mb; }
#pragma unroll
    for (int i = 0; i < 8; ++i) { if (act == 1) x[i] = fast_tanh(x[i]); else if (act == 2) x[i] = fast_sigmoid(x[i]); }
    const u4 o = (u4){pk2(x[0], x[1]), pk2(x[2], x[3]), pk2(x[4], x[5]), pk2(x[6], x[7])};
    return __builtin_bit_cast(s8, o);
}
template <class AT> __device__ __forceinline__ void rwkv_prep(const AT& A, int i, int gw, int NGW, int lane) {
    unsigned char* ws = A.ws;
    const bf16* z = (const bf16*)(ws + WS_Z);
    const bf16* w2t = (const bf16*)(ws + WS_LORA); const bf16* a2t = (const bf16*)(ws + WS_LORA + 65536); const bf16* g2t = (const bf16*)(ws + WS_LORA + 131072);
    bf16* Asig = (bf16*)(ws + WS_A); bf16* G = (bf16*)(ws + WS_A + 64 * MiB); float* Wl2 = (float*)(ws + WS_A + 128 * MiB);
    const float* mu = A.in[8] + (size_t)i * 1792; const float* w0 = A.in[9] + (size_t)i * 512; const float* a0 = A.in[11] + (size_t)i * 512;
    const int r32 = lane & 31, hi = lane >> 5;
    for (int job = gw; job < M / 32; job += NGW) {
        const int tok0 = 32 * job, tok = tok0 + r32; const bool hp = (tok & (T - 1)) != 0;
        const bf16* zr = z + (size_t)tok * ZE_LD; const bf16* zp = zr - ZE_LD;
#pragma unroll 1
        for (int which = 0; which < 3; ++which) {
            const int KS = (which == 2) ? 8 : 4;
            const int zc = (which == 0) ? 3072 : (which == 1 ? 3136 : 3200), mc = (which == 0) ? 1536 : (which == 1 ? 1600 : 1664);
            const bf16* wt = (which == 0) ? w2t : (which == 1 ? a2t : g2t); const int wld = (which == 2) ? 128 : 64;
            s8 Af[8];
#pragma unroll
            for (int ks = 0; ks < 8; ++ks) { if (ks < KS) { const int c = 16 * ks + 8 * hi; Af[ks] = lerp8(zr + zc + c, zp + zc + c, hp, mu + mc + c, which == 0 ? 1 : (which == 1 ? 0 : 2)); } else Af[ks] = Af[0]; }
#pragma unroll 1
            for (int nt = 0; nt < 16; ++nt) {
                const int n = 32 * nt + r32;
                f16v dd;
#pragma unroll
                for (int r = 0; r < 16; ++r) dd[r] = 0.f;
#pragma unroll
                for (int ks = 0; ks < 8; ++ks) { if (ks < KS) { const s8 bw = *(const s8*)(wt + (size_t)n * wld + 16 * ks + 8 * hi); dd = __builtin_amdgcn_mfma_f32_32x32x16_bf16(Af[ks], bw, dd, 0, 0, 0); } }
                const float c0n = (which == 0) ? w0[n] : (which == 1 ? a0[n] : 0.f);
#pragma unroll
                for (int r = 0; r < 16; ++r) {
                    const size_t o = (size_t)(tok0 + crow(r, hi)) * 512 + n;
                    if (which == 0) { const float wv = -softplusf(-(c0n + dd[r])) - 0.5f; Wl2[o] = -fast_exp(wv) * LOG2E; }
                    else if (which == 1) Asig[o] = (bf16)(pk2(fast_sigmoid(c0n + dd[r]), 0.f) & 0xffffu);
                    else G[o] = (bf16)(pk2(dd[r], 0.f) & 0xffffu);
                }
            }
        }
    }
}
template <class AT> __device__ __forceinline__ void fox_cumsum(const AT& A, int i, int b, LAS unsigned char* lds, int tid, int wave, int lane) {
    unsigned char* ws = A.ws;
    const bf16* z = (const bf16*)(ws + WS_Z) + (size_t)b * T * ZE_LD + 3328;
    float* c2 = (float*)(ws + WS_C2) + (size_t)b * T * 8;
    const float* bias = A.in[7] + i * 8;
    float bs[8];
#pragma unroll
    for (int h = 0; h < 8; ++h) bs[h] = bias[h];
    float acc[8];
#pragma unroll
    for (int h = 0; h < 8; ++h) acc[h] = 0.f;
    for (int t = 0; t < 16; ++t) {
        const u4 w = *(const u4*)(z + (size_t)(16 * tid + t) * ZE_LD);
        const unsigned ww[4] = {w.x, w.y, w.z, w.w};
#pragma unroll
        for (int k = 0; k < 4; ++k) { const float x0 = bflo(ww[k]) + bs[2 * k], x1 = bfhi(ww[k]) + bs[2 * k + 1]; acc[2 * k] += fminf(x0, 0.f) - log1p_small(fast_exp(-fabsf(x0))); acc[2 * k + 1] += fminf(x1, 0.f) - log1p_small(fast_exp(-fabsf(x1))); }
    }
    float inc[8];
#pragma unroll
    for (int h = 0; h < 8; ++h) { float v = acc[h];
#pragma unroll
        for (int o = 1; o < 64; o <<= 1) { const float u = __shfl_up(v, o); if (lane >= o) v += u; }
        inc[h] = v; }
    LAS float* tot = (LAS float*)lds;
    __syncthreads();
    if (lane == 63) {
#pragma unroll
        for (int h = 0; h < 8; ++h) tot[wave * 8 + h] = inc[h];
    }
    __syncthreads();
    float run[8];
#pragma unroll
    for (int h = 0; h < 8; ++h) { float p = 0.f; for (int w = 0; w < wave; ++w) p += tot[w * 8 + h]; run[h] = p + inc[h] - acc[h]; }
    for (int t = 0; t < 16; ++t) {
        const u4 w = *(const u4*)(z + (size_t)(16 * tid + t) * ZE_LD);
        const unsigned ww[4] = {w.x, w.y, w.z, w.w};
#pragma unroll
        for (int k = 0; k < 4; ++k) { const float x0 = bflo(ww[k]) + bs[2 * k], x1 = bfhi(ww[k]) + bs[2 * k + 1]; run[2 * k] += fminf(x0, 0.f) - log1p_small(fast_exp(-fabsf(x0))); run[2 * k + 1] += fminf(x1, 0.f) - log1p_small(fast_exp(-fabsf(x1))); }
        float* cp = c2 + (size_t)(16 * tid + t) * 8;
        *(f4*)cp = (f4){run[0] * LOG2E, run[1] * LOG2E, run[2] * LOG2E, run[3] * LOG2E};
        *(f4*)(cp + 4) = (f4){run[4] * LOG2E, run[5] * LOG2E, run[6] * LOG2E, run[7] * LOG2E};
    }
    __syncthreads();
}

__device__ __forceinline__ f4 bf4(u2 w) { return (f4){bflo(w.x), bfhi(w.x), bflo(w.y), bfhi(w.y)}; }
template <class AT> __device__ __forceinline__ void scan_job(const AT& A, int i, int b, int h, int half, LAS unsigned char* lds, int tid) {
    unsigned char* ws = A.ws;
    const int tt = tid >> 4, kg = tid & 15, rp = tid >> 4;
    const int hc = 64 * h + 4 * kg;
    const bf16* zb = (const bf16*)(ws + WS_Z) + (size_t)b * T * ZE_LD;
    const bf16* Asig = (const bf16*)(ws + WS_A) + (size_t)b * T * 512 + hc;
    const float* Wl2 = (const float*)(ws + WS_A + 128 * MiB) + (size_t)b * T * 512 + hc;
    bf16* Y = (bf16*)(ws + WS_Y) + (size_t)b * T * 1024 + 512 + 64 * h + 32 * half + 2 * kg;
    const float* mu = A.in[8] + (size_t)i * 1792;
    const f4 mu_r = *(const f4*)(mu + hc), mu_k = *(const f4*)(mu + 512 + hc), mu_v = *(const f4*)(mu + 1024 + hc);
    const f4 kk_k = *(const f4*)(A.in[14] + i * 512 + hc), k_a = *(const f4*)(A.in[15] + i * 512 + hc), r_k = *(const f4*)(A.in[16] + i * 512 + hc);
    float* BON = (float*)(ws + WS_ML) + (size_t)b * T * 8 + h;
    LAS float* Wd = (LAS float*)lds; LAS float* Av = Wd + 2048; LAS float* Bv = Av + 2048; LAS float* Kv = Bv + 2048; LAS float* Rv = Kv + 2048; LAS float* Vv = Rv + 2048; LAS float* Bon = Vv + 2048; LAS float* Yp = Bon + 64;
    f2 s0l = (f2){0.f, 0.f}, s0h = s0l, s1l = s0l, s1h = s0l;
    u2 zr, zk, zv, zrp, zkp, zvp, za; f4 wl;
#define SCAN_LOAD(c) do { const int t_ = 32 * (c) + tt; const bf16* zt_ = zb + (size_t)t_ * ZE_LD + hc; \
        zr = *(const u2*)(zt_ + 1536); zk = *(const u2*)(zt_ + 2048); zv = *(const u2*)(zt_ + 2560); \
        if (t_ > 0) { zrp = *(const u2*)(zt_ - ZE_LD + 1536); zkp = *(const u2*)(zt_ - ZE_LD + 2048); zvp = *(const u2*)(zt_ - ZE_LD + 2560); } else { zrp = zkp = zvp = (u2){0u, 0u}; } \
        za = *(const u2*)(Asig + (size_t)t_ * 512); wl = *(const f4*)(Wl2 + (size_t)t_ * 512); } while (0)
    __syncthreads();
    SCAN_LOAD(0);
#pragma unroll 1
    for (int c = 0; c < T / 32; ++c) {
        {
            const f4 rc = bf4(zr), kc = bf4(zk), vc = bf4(zv), rpv = bf4(zrp), kpv = bf4(zkp), vpv = bf4(zvp), av = bf4(za);
            const f4 r = rc + (rpv - rc) * mu_r, k = kc + (kpv - kc) * mu_k, v = vc + (vpv - vc) * mu_v;
            f4 kkv = k * kk_k;
            const float ss = red16((kkv.x * kkv.x + kkv.y * kkv.y) + (kkv.z * kkv.z + kkv.w * kkv.w));
            const float inv = __builtin_amdgcn_rsqf(fmaxf(ss, 1e-24f));
            kkv = kkv * inv;
            const f4 kp = k * (1.0f + (av - 1.0f) * k_a);
            const f4 rk = r * kp * r_k;
            const float bon = red16((rk.x + rk.y) + (rk.z + rk.w));
            const f4 wd = (f4){__builtin_amdgcn_exp2f(wl.x), __builtin_amdgcn_exp2f(wl.y), __builtin_amdgcn_exp2f(wl.z), __builtin_amdgcn_exp2f(wl.w)};
            *(LAS f4*)(Wd + tt * 64 + 4 * kg) = wd; *(LAS f4*)(Av + tt * 64 + 4 * kg) = -kkv; *(LAS f4*)(Bv + tt * 64 + 4 * kg) = kkv * av;
            *(LAS f4*)(Kv + tt * 64 + 4 * kg) = kp; *(LAS f4*)(Rv + tt * 64 + 4 * kg) = r; *(LAS f4*)(Vv + tt * 64 + 4 * kg) = v;
            if (kg == 0) Bon[tt] = bon;
        }
        __syncthreads();
        if (c + 1 < T / 32) SCAN_LOAD(c + 1);
        if (tid < 256) {
            const LAS float* pW = Wd + 4 * kg; const LAS float* pV = Vv + 32 * half + 2 * rp;
            f4 w4 = *(const LAS f4*)(pW), a4 = *(const LAS f4*)(pW + 2048), b4 = *(const LAS f4*)(pW + 4096), k4 = *(const LAS f4*)(pW + 6144), r4 = *(const LAS f4*)(pW + 8192); f2 v2 = *(const LAS f2*)(pV);
#pragma unroll 2
            for (int st = 0; st < 32; ++st) {
                const int sn = ((st + 1) & 31) * 64;
                const f4 w4n = *(const LAS f4*)(pW + sn), a4n = *(const LAS f4*)(pW + 2048 + sn), b4n = *(const LAS f4*)(pW + 4096 + sn), k4n = *(const LAS f4*)(pW + 6144 + sn), r4n = *(const LAS f4*)(pW + 8192 + sn); const f2 v2n = *(const LAS f2*)(pV + sn);
                const f2 a_lo = (f2){a4.x, a4.y}, a_hi = (f2){a4.z, a4.w}, w_lo = (f2){w4.x, w4.y}, w_hi = (f2){w4.z, w4.w}, b_lo = (f2){b4.x, b4.y}, b_hi = (f2){b4.z, b4.w};
                const f2 k_lo = (f2){k4.x, k4.y}, k_hi = (f2){k4.z, k4.w}, r_lo = (f2){r4.x, r4.y}, r_hi = (f2){r4.z, r4.w};
                f2 t0 = s0l * a_lo; t0 = s0h * a_hi + t0; f2 t1 = s1l * a_lo; t1 = s1h * a_hi + t1;
                float sa0 = t0.x + t0.y, sa1 = t1.x + t1.y;
                sa0 = red16(sa0); sa1 = red16(sa1);
                s0l = s0l * w_lo + (b_lo * sa0 + k_lo * v2.x); s0h = s0h * w_hi + (b_hi * sa0 + k_hi * v2.x);
                s1l = s1l * w_lo + (b_lo * sa1 + k_lo * v2.y); s1h = s1h * w_hi + (b_hi * sa1 + k_hi * v2.y);
                f2 u0 = s0l * r_lo; u0 = s0h * r_hi + u0; f2 u1 = s1l * r_lo; u1 = s1h * r_hi + u1;
                const float y0 = u0.x + u0.y, y1 = u1.x + u1.y;
                *(LAS f2*)(Yp + (st * 256 + tid) * 2) = (f2){y0, y1};
                w4 = w4n; a4 = a4n; b4 = b4n; k4 = k4n; r4 = r4n; v2 = v2n;
            }
        }
        __syncthreads();
        {
            const int t = 32 * c + tt;
            const LAS f4* yp = (const LAS f4*)(Yp + (tt * 256 + kg * 16) * 2);
            f4 acc4 = yp[0];
#pragma unroll
            for (int q = 1; q < 8; ++q) acc4 = acc4 + yp[q];
            const float y0 = acc4.x + acc4.z, y1 = acc4.y + acc4.w;
            *(unsigned*)(Y + (size_t)t * 1024) = pk2(y0, y1);
            if (half == 0 && kg == 8) BON[(size_t)t * 8] = Bon[tt];
        }
        __syncthreads();
    }
#undef SCAN_LOAD
}

template <class AT> __device__ __forceinline__ void rwkv_post(const AT& A, int i, int gtid, int NGT) {
    unsigned char* ws = A.ws;
    const bf16* Z = (const bf16*)(ws + WS_Z); const bf16* G = (const bf16*)(ws + WS_A + 64 * MiB); const float* BON = (const float*)(ws + WS_ML);
    bf16* Y = (bf16*)(ws + WS_Y);
    const float* mu = A.in[8] + (size_t)i * 1792;
    const int kg = gtid & 15;
    for (int p = gtid >> 4; p < M * 8; p += NGT >> 4) {
        const int tok = p >> 3, h = p & 7, hc = 64 * h + 4 * kg;
        const f4 lnw = *(const f4*)(A.in[17] + i * 512 + hc), lnb = *(const f4*)(A.in[18] + i * 512 + hc), mu_v = *(const f4*)(mu + 1024 + hc);
        bf16* yp = Y + (size_t)tok * 1024 + 512 + hc;
        const f4 yv = bf4(*(const u2*)yp);
        const bf16* zt = Z + (size_t)tok * ZE_LD + 2560 + hc;
        const f4 vc = bf4(*(const u2*)zt); f4 vpv = (f4){0.f, 0.f, 0.f, 0.f}; if ((tok & (T - 1)) != 0) vpv = bf4(*(const u2*)(zt - ZE_LD));
        const f4 vv = vc + (vpv - vc) * mu_v;
        const float bon = BON[(size_t)tok * 8 + h];
        const float mean = red16((yv.x + yv.y) + (yv.z + yv.w)) * (1.0f / 64.0f);
        const f4 d = yv - mean;
        const float var = red16((d.x * d.x + d.y * d.y) + (d.z * d.z + d.w * d.w)) * (1.0f / 64.0f);
        const float rs = __builtin_amdgcn_rsqf(var + GN_EPS);
        const f4 g = bf4(*(const u2*)(G + (size_t)tok * 512 + hc));
        const f4 o = (d * rs * lnw + lnb + vv * bon) * g;
        u2 w; w.x = pk2(o.x, o.y); w.y = pk2(o.z, o.w);
        *(u2*)yp = w;
    }
}


constexpr size_t WS_BAR = 16384;
#define XB_TMO      128
#define XB_XCNT(j)  (256  + 64 * (j))
#define XB_XSUB(j)  (1280 + 64 * (j))
#define XB_XGEN(j)  (2304 + 64 * (j))
#define XB_TOP      3328
#define XB_TOPGEN   3392
#define XCD_BAR_WORDS 3456
#define XB_SPIN_CAP (1u << 20)
__device__ __forceinline__ unsigned xb_ld(unsigned* p)              { return __hip_atomic_load(p, __ATOMIC_RELAXED, __HIP_MEMORY_SCOPE_AGENT); }
__device__ __forceinline__ unsigned xb_add(unsigned* p, unsigned v) { return __hip_atomic_fetch_add(p, v, __ATOMIC_RELAXED, __HIP_MEMORY_SCOPE_AGENT); }
__device__ __forceinline__ unsigned xb_xcc_id() { return (unsigned)__builtin_amdgcn_s_getreg((3 << 11) | 20) & 0xFu; }
#define XB_SPIN(cond, bar) do { unsigned _sp = 0; while (cond) { \
    if ((++_sp & 255u) == 0u) { if (xb_ld(&(bar)[XB_TMO])) break; if (_sp > XB_SPIN_CAP) { atomicAdd(&(bar)[XB_TMO], 1u); break; } } } } while (0)
__device__ __forceinline__ void xcd_barrier_complete(unsigned* bar, unsigned x, unsigned& nloc, unsigned& nx) {
    const unsigned G = gridDim.x * gridDim.y * gridDim.z;
    unsigned sum, cnt, mine, sp = 0u;
    for (;;) {
        sum = 0u; cnt = 0u; mine = 0u;
#pragma unroll
        for (unsigned j = 0; j < 16; ++j) { const unsigned c = xb_ld(&bar[XB_XCNT(j)]); sum += c; cnt += (c > 0u) ? 1u : 0u; mine = (j == x) ? c : mine; }
        if (sum == G) break;
        __builtin_amdgcn_s_sleep(1);
        if ((++sp & 255u) == 0u) { if (xb_ld(&bar[XB_TMO])) break; if (sp > XB_SPIN_CAP) { atomicAdd(&bar[XB_TMO], 1u); break; } }
    }
    nloc = mine > 0u ? mine : 1u; nx = cnt > 0u ? cnt : 1u;
}
__device__ __forceinline__ void xcd_barrier(unsigned* bar, volatile LAS unsigned* st, bool leader) {
    asm volatile("s_waitcnt vmcnt(0) lgkmcnt(0)" ::: "memory");
    __syncthreads();
    if (leader) {
        const unsigned x = xb_xcc_id();
        __builtin_amdgcn_s_waitcnt(0);
        unsigned nloc = st[0], nx = st[1];
        if (nloc == 0u) { xcd_barrier_complete(bar, x, nloc, nx); st[0] = nloc; st[1] = nx; }
        const unsigned old = xb_add(&bar[XB_XSUB(x)], 1u);
        const unsigned gen = old / nloc;
        if (old + 1u == (gen + 1u) * nloc) {
            __builtin_amdgcn_fence(__ATOMIC_RELEASE, "agent");
            asm volatile("s_waitcnt vmcnt(0)" ::: "memory");
            const unsigned og = xb_add(&bar[XB_TOP], 1u);
            const unsigned tg = og / nx;
            if (og + 1u == (tg + 1u) * nx) xb_add(&bar[XB_TOPGEN], 1u);
            else XB_SPIN(xb_ld(&bar[XB_TOPGEN]) == tg, bar);
            xb_add(&bar[XB_XGEN(x)], 1u);
            __builtin_amdgcn_fence(__ATOMIC_ACQUIRE, "agent");
            asm volatile("s_waitcnt vmcnt(0)" ::: "memory");
        } else {
            XB_SPIN(xb_ld(&bar[XB_XGEN(x)]) == gen, bar);
            __builtin_amdgcn_fence(__ATOMIC_ACQUIRE, "agent");
            asm volatile("s_waitcnt vmcnt(0)" ::: "memory");
        }
    }
    __syncthreads();
}
#define CG_SYNC() do { asm volatile("s_waitcnt vmcnt(0) lgkmcnt(0)" ::: "memory"); grid.sync(); __builtin_amdgcn_fence(__ATOMIC_ACQUIRE, "agent"); asm volatile("s_waitcnt vmcnt(0)" ::: "memory"); } while (0)
#define GRID_SYNC() do { PH_BEGIN xcd_barrier((unsigned*)(ws + WS_BAR), (volatile LAS unsigned*)(lds + LDS_MISC + 512), tid == 0); } while (0)
#define CAS __attribute__((address_space(4)))
typedef const CAS Args KArgs;
#define PH_BEGIN \
    int wave = wave0; asm volatile("" : "+s"(wave)); \
    int lane; asm volatile("v_mbcnt_lo_u32_b32 %0, -1, 0\n\tv_mbcnt_hi_u32_b32 %0, -1, %0" : "=v"(lane)); const int tid = wave * 64 + lane; \
    const int NG = gridDim.x, bid = blockIdx.x, gw = bid * NWAVES + wave, NGW = NG * NWAVES; \
    const CAS Args* Ap_ = (const CAS Args*)__builtin_amdgcn_kernarg_segment_ptr(); asm volatile("" : "+s"(Ap_)); KArgs& A = *Ap_; \
    unsigned char* ws = A.ws; (void)lane; (void)gw; (void)NGW; (void)tid; (void)wave; (void)bid; (void)ws;
#define P_WIN ((bf16*)(ws + WS_WIN))
#define P_WOUT ((bf16*)(ws + WS_WOUT))
#define P_WUP ((bf16*)(ws + WS_WUP))
#define P_WDN ((bf16*)(ws + WS_WDN))
#define P_H ((bf16*)(ws + WS_H))
#define P_Y ((bf16*)(ws + WS_Y))
#define P_Z ((bf16*)(ws + WS_Z))
#define P_CS ((float*)(ws + WS_CS))
#define P_C2 ((float*)(ws + WS_C2))
#define P_ML ((float*)(ws + WS_ML))
#define P_AUX ((bf16*)(ws + WS_A))
#define P_MB ((bf16*)(ws + WS_Z))
#define P_CTL ((unsigned*)(ws + WS_CTL))


#ifndef DBG_COL
#define DBG_COL 0
#endif
#ifndef DBG_STOP
#define DBG_STOP 0
#endif
#ifndef DBG_LAYER
#define DBG_LAYER 0
#endif
__device__ __forceinline__ void dbg_dump_bf16(const bf16* src, int ld, int col0, float* out, int gw, int NGW, int lane) {
    for (int row = gw; row < M; row += NGW) for (int c = lane; c < 1024; c += 64) { float v = bf2f(src[(size_t)row * ld + col0 + c]); if (DBG_STOP == 49 && !(fabsf(v) < 1e30f)) v = 12345.0f; out[(size_t)row * 1024 + c] = v; }
}
__device__ __forceinline__ void dbg_dump_f32(const float* src, int ld, int col0, int ncol, float* out, int gw, int NGW, int lane) {
    for (int row = gw; row < M; row += NGW) for (int c = lane; c < 1024; c += 64) out[(size_t)row * 1024 + c] = (c < ncol) ? src[(size_t)row * ld + col0 + c] : 0.f;
}
#define DBG_AT(k, stmt) do { if (DBG_STOP == (k) && layer == DBG_LAYER) { { PH_BEGIN stmt; } asm volatile("s_waitcnt vmcnt(0)" ::: "memory"); __builtin_amdgcn_endpgm(); } } while (0)

template <int layer> __device__ __forceinline__ void layer_body(LAS unsigned char* lds, const int wave0) {
    cg::grid_group grid = cg::this_grid();
    constexpr int i = layer >> 1; constexpr bool even = (layer & 1) == 0;
    if constexpr (even) {
        {
            PH_BEGIN
            pg8::Gemm g{P_H, P_WIN, M, 3584, 1024, 0}; pg8::StaticOrder S; S.init(M, 3584, NG, bid); pg8::EpiZ E{P_Z, ZE_LD, ZE_LD, nullptr, 0};
            pg8::gemm_phase<pg8::EpiZ, pg8::StaticOrder, true, true>(lds, g, S, E, tid);
        }
        GRID_SYNC();
        DBG_AT(2, dbg_dump_bf16(P_Z, ZE_LD, DBG_COL, A.out, gw, NGW, lane));
        {
            PH_BEGIN
            fox_kmax(ws, i, gw, NGW, lane);
            rwkv_prep(A, i, gw, NGW, lane);
            if (bid < NB) fox_cumsum(A, i, bid, lds, tid, wave, lane);
        }
        GRID_SYNC();
        DBG_AT(3, dbg_dump_f32((const float*)(ws + WS_A + 128 * MiB), 512, 0, 512, A.out, gw, NGW, lane));
        DBG_AT(31, dbg_dump_bf16((const bf16*)(ws + WS_A), 512, 0, A.out, gw, NGW, lane));
        DBG_AT(32, dbg_dump_f32(P_C2, 8, 0, 8, A.out, gw, NGW, lane));
        {
            PH_BEGIN
            LAS int* jobw = (LAS int*)(lds + LDS_MISC);
            for (;;) {
                __syncthreads();
                if (tid == 0) *jobw = (int)atomicAdd(P_CTL + 64 * i, 1u);
                __syncthreads();
                const int j = *jobw;
                if (j >= 128 + 2048) break;
                if (j < 128) scan_job(A, i, j >> 4, (j >> 1) & 7, j & 1, lds, tid);
                else {
                    const int jj = j - 128, qb = 31 - (jj >> 6), bh = jj & 63, b = bh >> 3, h = bh & 7;
                    AttnP P; P.q = P_Z + (size_t)b * T * ZE_LD + 64 * h; P.k = P.q + 512; P.v = P.q + 1024; P.ld = ZE_LD; P.stride = 1; P.resid = 0;
                    P.qi0 = 256 * qb; P.kbase = 0; P.jt0 = 0; P.jt1 = 4 * (qb + 1); P.W = 1 << 30; P.c2 = P_C2 + (size_t)b * T * 8 + h; P.kmax = sqrtf(__builtin_bit_cast(float, P_CTL[256 + 64 * i + b * 8 + h])); P.oacc = nullptr; P.ml = nullptr; P.load_state = 0; P.final = 1;
                    P.y = P_Y + (size_t)b * T * 1024 + 64 * h;
                    attn_unit<true>(P, lds, tid, wave, lane);
                }
            }
        }
        GRID_SYNC();
        {
            PH_BEGIN
            rwkv_post(A, i, bid * (NWAVES * 64) + tid, NG * NWAVES * 64);
        }
        GRID_SYNC();
        DBG_AT(4, dbg_dump_bf16(P_Y, 1024, 0, A.out, gw, NGW, lane));
    } else {
        {
            PH_BEGIN
            pg8::Gemm g{P_H, P_WIN, M, 3072, 1024, 0}; pg8::StaticOrder S; S.init(M, 3072, NG, bid); pg8::EpiZ E{P_Z, ZO_LD, ZO_LD, P_CS, 2048};
            pg8::gemm_phase<pg8::EpiZ, pg8::StaticOrder, true, true>(lds, g, S, E, tid);
        }
        GRID_SYNC();
        DBG_AT(2, dbg_dump_bf16(P_Z, ZO_LD, DBG_COL, A.out, gw, NGW, lane));
        {
            PH_BEGIN
            for (int job = bid; job < NB * 16 * 2; job += NG) {
                const int b = job >> 5, h = (job >> 1) & 15, R = job & 1;
#pragma unroll 1
                for (int gi = 0; gi < 3; ++gi) {
                    const int dl = (gi == 0) ? 1 : (gi == 1 ? 4 : 16);
#pragma unroll 1
                    for (int u = 0; u < 16; ++u) {
                        const int r = (gi == 0) ? 0 : (gi == 1 ? (u >> 2) : u), n2 = (gi == 0) ? (16 * R + u) : (gi == 1 ? (4 * R + (u & 3)) : R);
                        AttnP P; P.q = P_Z + (size_t)b * T * ZO_LD + 64 * h; P.k = P.q + 1024; P.v = P.q + 2048; P.ld = ZO_LD; P.stride = dl; P.resid = r;
                        P.qi0 = 256 * n2; P.kbase = P.qi0 - 128; P.jt0 = (n2 == 0) ? 2 : 0; P.jt1 = 6; P.W = 128; P.c2 = nullptr; P.kmax = 0.f;
                        P.oacc = P_AUX + (size_t)b * T * 1024 + 64 * h; P.ml = P_ML + (size_t)b * T * 32 + 2 * h; P.load_state = gi > 0; P.final = gi == 2;
                        P.y = P_Y + (size_t)b * T * 1024 + 64 * h;
                        attn_band_unit(P, lds, tid, wave, lane);
                    }
                    asm volatile("s_waitcnt vmcnt(0)" ::: "memory"); __syncthreads();
                    if (tid == 0) { __builtin_amdgcn_fence(__ATOMIC_ACQUIRE, "agent"); asm volatile("s_waitcnt vmcnt(0)" ::: "memory"); }
                    __syncthreads();
                }
            }
        }
        GRID_SYNC();
        DBG_AT(4, dbg_dump_bf16(P_Y, 1024, 0, A.out, gw, NGW, lane));
    }
    {
        PH_BEGIN
        pg8::Gemm g{P_Y, P_WOUT, M, 1024, 1024, 0}; pg8::StaticOrder S; S.init(M, 1024, NG, bid); pg8::EpiZ E{P_MB, 1024, 1024, nullptr, 0};
        pg8::gemm_phase<pg8::EpiZ, pg8::StaticOrder, true, true>(lds, g, S, E, tid);
    }
    GRID_SYNC();
    DBG_AT(5, dbg_dump_bf16(P_MB, 1024, 0, A.out, gw, NGW, lane));
    {
        PH_BEGIN
        row_phase((layer == 0) ? A.in[0] : A.out, P_MB, A.in[3] + layer * D, A.out, A.in[4] + layer * D, P_H, gw, NGW, lane);
    }
    GRID_SYNC();
    DBG_AT(6, (void)0);
    {
        PH_BEGIN
        pg8::Gemm g{P_H, P_WUP, 264 * 256, 5632, 1024, 1}; pg8::StaticOrder S; S.init(264 * 256, 5632, NG, bid);
        pg8::EpiConv E{P_Z, A.in[23] + (size_t)layer * 3 * 5632, A.in[24] + (size_t)layer * 5632, (LAS float*)(lds + LDS_X)};
        pg8::gemm_phase<pg8::EpiConv, pg8::StaticOrder, true, true>(lds, g, S, E, tid);
    }
    GRID_SYNC();
    DBG_AT(7, dbg_dump_bf16(P_Z, 2816, DBG_COL, A.out, gw, NGW, lane));
    {
        PH_BEGIN
        pg8::Gemm g{P_Z, P_WDN, M, 1024, FF, 0}; pg8::StaticOrder S; S.init(M, 1024, NG, bid); pg8::EpiZ E{P_AUX, 1024, 1024, nullptr, 0};
        pg8::gemm_phase<pg8::EpiZ, pg8::StaticOrder, true, true>(lds, g, S, E, tid);
    }
    GRID_SYNC();
    DBG_AT(8, dbg_dump_bf16(P_AUX, 1024, 0, A.out, gw, NGW, lane));
    {
        PH_BEGIN
        if constexpr (layer + 1 < DEPTH) { row_phase(A.out, P_AUX, A.in[5] + layer * D, A.out, A.in[2] + (layer + 1) * D, P_H, gw, NGW, lane); convert_layer_weights(A, layer + 1, lds, gw, NGW, wave, lane); }
        else row_phase(A.out, P_AUX, A.in[5] + layer * D, A.out, nullptr, nullptr, gw, NGW, lane);
    }
    if constexpr (layer + 1 < DEPTH) GRID_SYNC();
    DBG_AT(9, (void)0);
}

__global__ void __launch_bounds__(NWAVES * 64, 2) mega_fwd(Args Aarg) {
    extern __shared__ __attribute__((aligned(16))) unsigned char lds_raw[];
    LAS unsigned char* lds = (LAS unsigned char*)lds_raw;
    cg::grid_group grid = cg::this_grid();
    const int wave0 = __builtin_amdgcn_readfirstlane((int)threadIdx.x >> 6);
    {
        PH_BEGIN
        if (tid == 0) { volatile LAS unsigned* st = (volatile LAS unsigned*)(lds + LDS_MISC + 512); st[0] = 0u; st[1] = 0u; (void)xb_add((unsigned*)(ws + WS_BAR) + XB_XCNT(xb_xcc_id()), 1u); }
    }
    {
        PH_BEGIN
        convert_layer_weights(A, 0, lds, gw, NGW, wave, lane);
        const int* pos = (const int*)A.in[1];
        for (int idx = bid * (NWAVES * 64) + tid; idx < M * 8; idx += NG * NWAVES * 64) {
            const int tok = idx >> 3, d = idx & 7;
            const float ang = (float)pos[tok] * A.inv_freq[d];
            const double rev = (double)ang * 0.15915494309189535; const float fr = (float)(rev - __builtin_rint(rev));
            P_CS[(size_t)tok * 16 + d] = __builtin_amdgcn_cosf(fr); P_CS[(size_t)tok * 16 + 8 + d] = __builtin_amdgcn_sinf(fr);
        }
        row_phase(A.in[0], nullptr, nullptr, nullptr, A.in[2], P_H, gw, NGW, lane);
        if (bid == 0) P_CTL[tid] = 0u;
        if (A.out == nullptr) CG_SYNC();
    }
    GRID_SYNC();
    layer_body<0>(lds, wave0); layer_body<1>(lds, wave0); layer_body<2>(lds, wave0); layer_body<3>(lds, wave0);
}

extern "C" void kernel_launch(void* const* d_in, const int* in_sizes, int n_in, void* d_out, int out_size, void* d_ws, size_t ws_size, hipStream_t stream) {
    static int grid = 0;
    if (grid == 0) {
        if (n_in != 26 || out_size != M * D || ws_size < WS_END) { fprintf(stderr, "kernel_launch: unexpected problem (n_in %d out %d ws %zu need %zu)\n", n_in, out_size, ws_size, (size_t)WS_END); grid = -1; return; }
        int dev = 0, cus = 0, per_cu = 0;
        hipGetDevice(&dev); hipDeviceGetAttribute(&cus, hipDeviceAttributeMultiprocessorCount, dev);
        if (hipFuncSetAttribute((const void*)mega_fwd, hipFuncAttributeMaxDynamicSharedMemorySize, LDS_BYTES) != hipSuccess) { fprintf(stderr, "kernel_launch: hipFuncSetAttribute failed\n"); grid = -1; return; }
        hipOccupancyMaxActiveBlocksPerMultiprocessor(&per_cu, (const void*)mega_fwd, NWAVES * 64, LDS_BYTES);
        if (per_cu < 1) { fprintf(stderr, "kernel_launch: occupancy query says %d blocks per CU\n", per_cu); per_cu = 1; }
        (void)hipGetLastError();
        grid = cus * 1;
    }
    if (grid < 0) return;
    if (hipMemsetAsync((char*)d_ws + WS_BAR, 0, XCD_BAR_WORDS * 4, stream) != hipSuccess) { fprintf(stderr, "kernel_launch: hipMemsetAsync failed\n"); return; }
    Args a{};
    for (int i = 0; i < 26; ++i) a.in[i] = (const float*)d_in[i];
    a.out = (float*)d_out; a.ws = (unsigned char*)d_ws;
    for (int d = 0; d < 8; ++d) a.inv_freq[d] = (float)pow(500000.0, -(double)(2 * d) / 16.0);
    void* args[] = {&a};
    hipError_t e = hipLaunchCooperativeKernel((const void*)mega_fwd, dim3(grid), dim3(NWAVES * 64), args, LDS_BYTES, stream);
    if (e != hipSuccess) fprintf(stderr, "cooperative launch failed: %s (grid %d)\n", hipGetErrorString(e), grid);
}
```

```cpp
#include <hip/hip_runtime.h>
#include <hip/hip_cooperative_groups.h>
#include <cstdio>
#include <cstdint>
#include <cmath>
namespace cg = cooperative_groups;
namespace pg8 {
#define PG8_LAS __attribute__((address_space(3)))
typedef unsigned short bf16_t;
typedef short bf16x8 __attribute__((ext_vector_type(8)));
typedef float f32x4 __attribute__((ext_vector_type(4)));
typedef unsigned u32x4 __attribute__((ext_vector_type(4)));
constexpr int BM = 256, BK = 64, HALF = 128, HTB = HALF * BK * 2  , STAGE_BYTES = 8 * HTB, NXCD = 8, WGM = 8;

__host__ __device__ __forceinline__ int lds_byte(int r, int c) { const int st = (r >> 4) * 2 + (c >> 5), rr = r & 15, cc = c & 31, ob = rr * 64 + cc * 2; return st * 1024 + (ob ^ (((ob >> 9) & 1) << 5)); }
__host__ __device__ __forceinline__ void stage_rc(int b, int& R, int& C) { const int st = b / 1024, sb = b % 1024, swz = sb ^ (((sb >> 9) & 1) << 5); R = (st >> 1) * 16 + swz / 64; C = (st & 1) * 32 + (swz % 64) / 2; }
__host__ __device__ __forceinline__ int perm32(int rho) { const int n = rho >> 4, i = rho & 15; return 8 * (i >> 2) + 4 * n + (i & 3); }

struct Unit { int pm, pn; };
struct Gemm { const bf16_t* A; const bf16_t* Bt; int M, N, K; int halo; };
__device__ __forceinline__ const char* a_ptr(const Gemm& g, int pm, size_t tstep) { if (g.halo) { const long row0 = (long)(pm / 33) * 8192 + (long)(pm % 33) * 254 - 2; return (const char*)g.A + row0 * (long)g.K * 2; } return (const char*)g.A + (size_t)pm * tstep; }

struct StaticOrder {
    int nM, nN, nwg, G, c;
    __host__ __device__ void init(int M, int N, int G_, int c_) { nM = M / BM; nN = N / BM; nwg = nM * nN; G = G_; c = c_; }
    __host__ __device__ bool next(int i, Unit& u) const {
        const long L = (long)i * G + c; if (L >= nwg) return false;
        int wgid = (int)L; { const int q = nwg / NXCD, r = nwg % NXCD, xcd = wgid % NXCD, off = wgid / NXCD; wgid = (xcd < r ? xcd * (q + 1) : r * (q + 1) + (xcd - r) * q) + off; }
        const int nig = WGM * nN, gid = wgid / nig, fm = gid * WGM, gsz = (nM - fm) < WGM ? (nM - fm) : WGM;
        u.pm = fm + ((wgid % nig) % gsz); u.pn = (wgid % nig) / gsz; return true;
    }
    __device__ __forceinline__ void a_ready(const Unit&) const {}
    __device__ __forceinline__ void done(const Unit&) const {}
};


typedef float f32x2 __attribute__((ext_vector_type(2)));
typedef __bf16 bf16x2_t __attribute__((ext_vector_type(2)));
__device__ __forceinline__ unsigned cvt_pk_bf16(float lo, float hi) { f32x2 v = {lo, hi}; bf16x2_t b = __builtin_convertvector(v, bf16x2_t); return __builtin_bit_cast(unsigned, b); }
template <int CTRL> __device__ __forceinline__ float dpp_old(float oldv, float x) { return __builtin_bit_cast(float, __builtin_amdgcn_update_dpp(__builtin_bit_cast(int, oldv), __builtin_bit_cast(int, x), CTRL, 0xf, 0xf, false)); }
template <int CTRL> __device__ __forceinline__ float dppf(float x) { return __builtin_bit_cast(float, __builtin_amdgcn_mov_dpp(__builtin_bit_cast(int, x), CTRL, 0xf, 0xf, true)); }

struct EpiZ {
    static constexpr bool PERM = true, AFTER_DRAIN = false;
    bf16_t* O; int ldc; int ncols; const float* cs; int rot_cols;
    __device__ __forceinline__ void operator()(const f32x4 (&acc)[2][2][4][2], const Unit& u, int wr, int wc, int fr, int fq) const {
        const int row0 = u.pm * BM + wr * 64 + fr;
#pragma unroll
        for (int bj = 0; bj < 2; ++bj) {
            const int col = u.pn * BM + bj * HALF + wc * 32 + 8 * fq;
            if (col >= ncols) continue;
            const bool rot = (cs != nullptr) && (col < rot_cols) && ((col & 63) < 16);
#pragma unroll
            for (int ai = 0; ai < 2; ++ai)
#pragma unroll
                for (int m = 0; m < 4; ++m) {
                    const int row = row0 + ai * HALF + m * 16;
                    f32x4 v0 = acc[ai][bj][m][0], v1 = acc[ai][bj][m][1];
                    if (rot) {
                        const float* t = cs + (size_t)row * 16 + ((col & 63) >> 1);
                        const f32x4 c4 = *(const f32x4*)t, s4 = *(const f32x4*)(t + 8);
                        f32x4 w0, w1;
                        w0[0] = v0[0] * c4[0] - v0[1] * s4[0]; w0[1] = v0[0] * s4[0] + v0[1] * c4[0];
                        w0[2] = v0[2] * c4[1] - v0[3] * s4[1]; w0[3] = v0[2] * s4[1] + v0[3] * c4[1];
                        w1[0] = v1[0] * c4[2] - v1[1] * s4[2]; w1[1] = v1[0] * s4[2] + v1[1] * c4[2];
                        w1[2] = v1[2] * c4[3] - v1[3] * s4[3]; w1[3] = v1[2] * s4[3] + v1[3] * c4[3];
                        v0 = w0; v1 = w1;
                    }
                    u32x4 w; w.x = cvt_pk_bf16(v0[0], v0[1]); w.y = cvt_pk_bf16(v0[2], v0[3]); w.z = cvt_pk_bf16(v1[0], v1[1]); w.w = cvt_pk_bf16(v1[2], v1[3]);
                    *(u32x4*)(O + (size_t)row * ldc + col) = w;
                }
        }
    }
};

struct EpiF32 {
    static constexpr bool PERM = false, AFTER_DRAIN = false;
    float* O; int ldc;
    __device__ __forceinline__ void operator()(const f32x4 (&acc)[2][2][4][2], const Unit& u, int wr, int wc, int fr, int fq) const {
        const int row0 = u.pm * BM + wr * 64 + fr, col0 = u.pn * BM + wc * 32 + 4 * fq;
#pragma unroll
        for (int ai = 0; ai < 2; ++ai)
#pragma unroll
            for (int m = 0; m < 4; ++m) {
                float* rowp = O + (size_t)(row0 + ai * HALF + m * 16) * ldc + col0;
#pragma unroll
                for (int bj = 0; bj < 2; ++bj)
#pragma unroll
                    for (int n = 0; n < 2; ++n) *(f32x4*)(rowp + bj * HALF + n * 16) = acc[ai][bj][m][n];
            }
    }
};

struct EpiConv {
    static constexpr bool PERM = true, AFTER_DRAIN = false;
    bf16_t* O; const float* cw; const float* cb; PG8_LAS float* X;
    __device__ __forceinline__ void operator()(const f32x4 (&acc)[2][2][4][2], const Unit& u, int wr, int wc, int fr, int fq) const {
        int xw = wr * 512 + wc * 128 + fq * 8 + (fr & 1), xr = (wr == 1 ? 0 : 512 - 1024) + wc * 128 + fq * 8;
        asm volatile("" : "+v"(xw), "+v"(xr));
        PG8_LAS float* Xw = X + xw; const PG8_LAS float* Xr = X + xr;
#pragma unroll
        for (int ai = 0; ai < 2; ++ai)
#pragma unroll
            for (int bj = 0; bj < 2; ++bj)
#pragma unroll
                for (int n = 0; n < 2; ++n)
#pragma unroll
                    for (int j = 0; j < 4; ++j)
                        if (fr >= 14) Xw[ai * 1024 + bj * 64 + n * 32 + j * 2] = acc[ai][bj][3][n][j];
        asm volatile("s_waitcnt lgkmcnt(0)" ::: "memory"); __builtin_amdgcn_s_barrier(); asm volatile("" ::: "memory");
        const int b = u.pm / 33, it = u.pm % 33;
        const int tbase = 254 * it - 2 + wr * 64 + fr;
        const bool zsrc = (it == 0) && (wr == 0) && (fr < 2);
        const int rrmax = (it == 32) ? 66 : 256;
#pragma unroll
        for (int n = 0; n < 2; ++n) {
            asm volatile("" ::: "memory");
            const int ch = u.pn * HALF + wc * 32 + 8 * fq + 4 * n;
            const f32x4 gw0 = *(const f32x4*)(cw + ch), gw1 = *(const f32x4*)(cw + 5632 + ch), gw2 = *(const f32x4*)(cw + 2 * 5632 + ch), gb = *(const f32x4*)(cb + ch);
            const f32x4 vw0 = *(const f32x4*)(cw + 2816 + ch), vw1 = *(const f32x4*)(cw + 5632 + 2816 + ch), vw2 = *(const f32x4*)(cw + 2 * 5632 + 2816 + ch), vb = *(const f32x4*)(cb + 2816 + ch);
#pragma unroll
            for (int ai = 0; ai < 2; ++ai) {
                f32x4 gP1, gP2, vP1, vP2;
                if (ai == 0 && wr == 0) { gP1 = gP2 = vP1 = vP2 = (f32x4){0.f, 0.f, 0.f, 0.f}; }
                else {
#pragma unroll
                    for (int j = 0; j < 4; ++j) {
                        const f32x2 ge = *(const PG8_LAS f32x2*)&Xr[ai * 1024 + 0 * 64 + n * 32 + j * 2];
                        const f32x2 ve = *(const PG8_LAS f32x2*)&Xr[ai * 1024 + 1 * 64 + n * 32 + j * 2];
                        gP1[j] = ge.y; gP2[j] = (fr == 0) ? ge.x : ge.y; vP1[j] = ve.y; vP2[j] = (fr == 0) ? ve.x : ve.y;
                    }
                }
#pragma unroll
                for (int m = 0; m < 4; ++m) {
                    f32x4 g = acc[ai][0][m][n], v = acc[ai][1][m][n];
                    if (ai == 0 && m == 0) { if (zsrc) { g = (f32x4){0.f, 0.f, 0.f, 0.f}; v = g; } }
                    f32x4 a4;
#pragma unroll
                    for (int j = 0; j < 4; ++j) {
                        const float g1 = dpp_old<0x111>(gP1[j], g[j]), g2 = dpp_old<0x112>(gP2[j], g[j]), v1 = dpp_old<0x111>(vP1[j], v[j]), v2 = dpp_old<0x112>(vP2[j], v[j]);
                        const float gc = gb[j] + gw0[j] * g2 + gw1[j] * g1 + gw2[j] * g[j];
                        const float vc = vb[j] + vw0[j] * v2 + vw1[j] * v1 + vw2[j] * v[j];
                        const float y2 = gc * (1.0f + 0.044715f * gc * gc) * (2.0f * 0.7978845608028654f * 1.4426950408889634f);
                        const float e = __builtin_amdgcn_exp2f(y2);
                        const float ge_ = gc - gc * __builtin_amdgcn_rcpf(1.0f + e);
                        a4[j] = ge_ * vc;
                        gP1[j] = dppf<0x121>(g[j]); vP1[j] = dppf<0x121>(v[j]); gP2[j] = dppf<0x122>(g[j]); vP2[j] = dppf<0x122>(v[j]);
                    }
                    const int rr = wr * 64 + fr + ai * HALF + m * 16;
                    if (rr >= 2 && rr < rrmax) {
                        typedef unsigned u32x2 __attribute__((ext_vector_type(2)));
                        u32x2 w; w.x = cvt_pk_bf16(a4[0], a4[1]); w.y = cvt_pk_bf16(a4[2], a4[3]);
                        *(u32x2*)(O + ((size_t)b * 8192 + (tbase + ai * HALF + m * 16)) * 2816 + ch) = w;
                    }
                }
            }
        }
    }
};
template <class Epi, class Sched, bool ALIGN_EPI = false, bool SP2 = false>
__device__ __forceinline__ void gemm_phase(PG8_LAS unsigned char* lds, const Gemm g, const Sched& S, const Epi& E, const int tid_in) {
    const int tid = tid_in, wid = __builtin_amdgcn_readfirstlane(tid >> 6), lane = tid & 63, wr = wid >> 2, wc = wid & 3, fr = lane & 15, fq = lane >> 4;
    const int K = g.K, nt = K / BK;
    unsigned voffA[2], voffB[2];
#pragma unroll
    for (int i = 0; i < 2; ++i) { int R, C; stage_rc(tid * 16 + i * 8192, R, C); const int Rb = Epi::PERM ? ((R & ~31) + perm32(R & 31)) : R;
        voffA[i] = (unsigned)(R * K + C) * 2u; voffB[i] = (unsigned)(Rb * K + C) * 2u; }
    const size_t kstep = (size_t)(BK * 2);
    const size_t hstep = (size_t)HALF * K * 2;
    const size_t tstep = 2 * hstep;
    const unsigned ldsw = (unsigned)wid * 1024u;
    const int aoff = lds_byte(wr * 64 + fr, fq * 8), boff = lds_byte(wc * 32 + fr, fq * 8);
#define PG8_SA(b, h) (((b) * 2 + (h)) * HTB)
#define PG8_SB(b, h) ((4 + (b) * 2 + (h)) * HTB)
#define PG8_STAGE(bufoff, gbase, voff) do { _Pragma("unroll") for (int _i = 0; _i < 2; ++_i) \
        __builtin_amdgcn_global_load_lds((const unsigned*)((const char*)(gbase) + (voff)[_i]), (PG8_LAS unsigned*)(lds + (bufoff) + ldsw + _i * 8192), 16, 0, 0); } while (0)
#define PG8_LDA(dst, b, h) do { _Pragma("unroll") for (int m = 0; m < 4; ++m) _Pragma("unroll") for (int k = 0; k < 2; ++k) dst[m][k] = *(const PG8_LAS bf16x8*)(lds + PG8_SA(b, h) + aoff + m * 2048 + k * 1024); } while (0)
#define PG8_LDB(dst, b, h) do { _Pragma("unroll") for (int n = 0; n < 2; ++n) _Pragma("unroll") for (int k = 0; k < 2; ++k) dst[n][k] = *(const PG8_LAS bf16x8*)(lds + PG8_SB(b, h) + boff + n * 2048 + k * 1024); } while (0)
#define PG8_MMA(ai, bj, At, Bt) do { __builtin_amdgcn_s_setprio(1); _Pragma("unroll") for (int m = 0; m < 4; ++m) _Pragma("unroll") for (int n = 0; n < 2; ++n) _Pragma("unroll") for (int k = 0; k < 2; ++k) \
        acc[ai][bj][m][n] = __builtin_amdgcn_mfma_f32_16x16x32_bf16(Bt[n][k], At[m][k], acc[ai][bj][m][n], 0, 0, 0); __builtin_amdgcn_s_setprio(0); } while (0)
#define PG8_WAIT_V(n) asm volatile("s_waitcnt vmcnt(" #n ")" ::: "memory")
#define PG8_WAIT_L(n) asm volatile("s_waitcnt lgkmcnt(" #n ")" ::: "memory")
#define PG8_BAR __builtin_amdgcn_s_barrier()
#define PG8_SCHED __builtin_amdgcn_sched_barrier(0)
    Unit cur, nxt; int ui = 0;
    if (!S.next(0, cur)) return;
    f32x4 acc[2][2][4][2];
#pragma unroll
    for (int a = 0; a < 2; ++a)
#pragma unroll
        for (int b = 0; b < 2; ++b)
#pragma unroll
            for (int m = 0; m < 4; ++m)
#pragma unroll
                for (int n = 0; n < 2; ++n) acc[a][b][m][n] = (f32x4){0.f, 0.f, 0.f, 0.f};
    bf16x8 At[4][2], B0[2][2], B1[2][2];
    const char* cA = a_ptr(g, cur.pm, tstep); const char* cB = (const char*)g.Bt + (size_t)cur.pn * tstep;
    S.a_ready(cur);
    if constexpr (SP2) {
        PG8_STAGE(PG8_SB(0, 0), cB, voffB); PG8_STAGE(PG8_SB(0, 1), cB + hstep, voffB); PG8_STAGE(PG8_SA(0, 0), cA, voffA); PG8_STAGE(PG8_SA(0, 1), cA + hstep, voffA);
        if (wr == 1) PG8_BAR;
        PG8_WAIT_V(2); PG8_BAR;
        PG8_STAGE(PG8_SB(1, 0), cB + kstep, voffB); PG8_STAGE(PG8_SA(1, 0), cA + kstep, voffA); PG8_STAGE(PG8_SB(1, 1), cB + hstep + kstep, voffB);
        PG8_WAIT_V(6); PG8_BAR;
    } else {
        PG8_STAGE(PG8_SB(0, 0), cB, voffB); PG8_STAGE(PG8_SA(0, 0), cA, voffA); PG8_STAGE(PG8_SB(0, 1), cB + hstep, voffB); PG8_STAGE(PG8_SA(0, 1), cA + hstep, voffA);
        if (wr == 1) PG8_BAR;
        PG8_WAIT_V(4); PG8_BAR;
        PG8_STAGE(PG8_SB(1, 0), cB + kstep, voffB); PG8_STAGE(PG8_SA(1, 0), cA + kstep, voffA); PG8_STAGE(PG8_SB(1, 1), cB + hstep + kstep, voffB);
        PG8_WAIT_V(6); PG8_BAR;
    }
    for (;;) {
        const bool has_next = S.next(ui + 1, nxt);
        const char* nA = has_next ? a_ptr(g, nxt.pm, tstep) : cA; const char* nB = has_next ? (const char*)g.Bt + (size_t)nxt.pn * tstep : cB;
        for (int t = 0; t < nt; t += 2) {
            const bool last = (t == nt - 2);
            const char* a1 = cA + (size_t)(t + 1) * kstep;
            const char* a2 = last ? nA : cA + (size_t)(t + 2) * kstep; const char* b2 = last ? nB : cB + (size_t)(t + 2) * kstep;
            const char* a3 = a2 + kstep; const char* b3 = b2 + kstep;
            if (last && has_next) S.a_ready(nxt);
            if constexpr (SP2) {
            PG8_LDB(B0, 0, 0); PG8_LDB(B1, 0, 1); PG8_SCHED; PG8_LDA(At, 0, 0); PG8_STAGE(PG8_SA(1, 1), a1 + hstep, voffA);
            PG8_WAIT_V(8); PG8_WAIT_L(0); PG8_BAR; PG8_MMA(0, 0, At, B0); PG8_MMA(0, 1, At, B1); PG8_BAR; PG8_SCHED;
            PG8_LDA(At, 0, 1); PG8_STAGE(PG8_SB(0, 0), b2, voffB); PG8_STAGE(PG8_SB(0, 1), b2 + hstep, voffB); PG8_STAGE(PG8_SA(0, 0), a2, voffA);
            PG8_WAIT_V(8); PG8_WAIT_L(0); PG8_BAR; PG8_MMA(1, 0, At, B0); PG8_MMA(1, 1, At, B1); PG8_BAR; PG8_SCHED;
            PG8_LDB(B0, 1, 0); PG8_LDB(B1, 1, 1); PG8_SCHED; PG8_LDA(At, 1, 0); PG8_STAGE(PG8_SA(0, 1), a2 + hstep, voffA);
            PG8_WAIT_V(8); PG8_WAIT_L(0); PG8_BAR; PG8_MMA(0, 0, At, B0); PG8_MMA(0, 1, At, B1); PG8_BAR; PG8_SCHED;
            PG8_LDA(At, 1, 1); PG8_STAGE(PG8_SB(1, 0), b3, voffB); PG8_STAGE(PG8_SB(1, 1), b3 + hstep, voffB); PG8_STAGE(PG8_SA(1, 0), a3, voffA);
            PG8_WAIT_V(8); PG8_WAIT_L(0); PG8_BAR; PG8_MMA(1, 0, At, B0); PG8_MMA(1, 1, At, B1); PG8_BAR; PG8_SCHED;
            } else {
            PG8_LDB(B0, 0, 0); PG8_SCHED; PG8_LDA(At, 0, 0); PG8_STAGE(PG8_SA(1, 1), a1 + hstep, voffA);
            PG8_WAIT_L(8); PG8_BAR; PG8_WAIT_L(0); PG8_MMA(0, 0, At, B0); PG8_BAR; PG8_SCHED;
            PG8_LDB(B1, 0, 1); PG8_STAGE(PG8_SB(0, 0), b2, voffB);
            PG8_BAR; PG8_WAIT_L(0); PG8_MMA(0, 1, At, B1); PG8_BAR;
            PG8_LDA(At, 0, 1); PG8_STAGE(PG8_SA(0, 0), a2, voffA);
            PG8_BAR; PG8_WAIT_L(0); PG8_MMA(1, 0, At, B0); PG8_BAR; PG8_SCHED;
            PG8_STAGE(PG8_SB(0, 1), b2 + hstep, voffB);
            PG8_WAIT_V(6); PG8_BAR; PG8_MMA(1, 1, At, B1); PG8_BAR;
            PG8_LDB(B0, 1, 0); PG8_SCHED; PG8_LDA(At, 1, 0); PG8_STAGE(PG8_SA(0, 1), a2 + hstep, voffA);
            PG8_WAIT_L(8); PG8_BAR; PG8_WAIT_L(0); PG8_MMA(0, 0, At, B0); PG8_BAR; PG8_SCHED;
            PG8_LDB(B1, 1, 1); PG8_STAGE(PG8_SB(1, 0), b3, voffB);
            PG8_BAR; PG8_WAIT_L(0); PG8_MMA(0, 1, At, B1); PG8_BAR;
            PG8_LDA(At, 1, 1); PG8_STAGE(PG8_SA(1, 0), a3, voffA);
            PG8_BAR; PG8_WAIT_L(0); PG8_MMA(1, 0, At, B0); PG8_BAR; PG8_SCHED;
            PG8_STAGE(PG8_SB(1, 1), b3 + hstep, voffB);
            PG8_WAIT_V(6); PG8_BAR; PG8_MMA(1, 1, At, B1); PG8_BAR;
            }
        }
        if constexpr (ALIGN_EPI) { if (wr == 0) PG8_BAR; }
        if constexpr (!Epi::AFTER_DRAIN) { E(acc, cur, wr, wc, fr, fq); S.done(cur); }
        if (!has_next) break;
#pragma unroll
        for (int a = 0; a < 2; ++a)
#pragma unroll
            for (int b = 0; b < 2; ++b)
#pragma unroll
                for (int m = 0; m < 4; ++m)
#pragma unroll
                    for (int n = 0; n < 2; ++n) acc[a][b][m][n] = (f32x4){0.f, 0.f, 0.f, 0.f};
        cur = nxt; cA = nA; cB = nB; ++ui;
        if constexpr (ALIGN_EPI) { if (wr == 1) PG8_BAR; }
    }
    PG8_WAIT_V(0);
    if constexpr (!ALIGN_EPI) { if (wr == 0) PG8_BAR; }
    PG8_BAR;
    if constexpr (Epi::AFTER_DRAIN) { E.fused(acc, cur, wr, wc, fr, fq, lds, wid, lane); S.done(cur); }
#undef PG8_SA
#undef PG8_SB
#undef PG8_STAGE
#undef PG8_LDA
#undef PG8_LDB
#undef PG8_MMA
#undef PG8_WAIT_V
#undef PG8_WAIT_L
#undef PG8_BAR
#undef PG8_SCHED
}
}

#define LAS __attribute__((address_space(3)))
typedef unsigned short bf16;
typedef float f4 __attribute__((ext_vector_type(4)));
typedef float f2 __attribute__((ext_vector_type(2)));
typedef float f16v __attribute__((ext_vector_type(16)));
typedef short s8 __attribute__((ext_vector_type(8)));
typedef short s4v __attribute__((ext_vector_type(4)));
typedef unsigned u4 __attribute__((ext_vector_type(4)));
typedef unsigned u2 __attribute__((ext_vector_type(2)));

constexpr int NB = 8, T = 8192, D = 1024, M = NB * T, DEPTH = 4;
constexpr int ZE_LD = 3344, ZO_LD = 3072, FF = 2816, NWAVES = 8;
constexpr float LOG2E = 1.4426950408889634f;
constexpr float SCL = 0.125f * LOG2E;
constexpr float RMS_EPS = 1e-6f, GN_EPS = 64e-5f;

constexpr size_t MiB = 1u << 20;
constexpr size_t WS_CTL = 0, WS_WIN = 1 * MiB, WS_WOUT = 8 * MiB, WS_WUP = 10 * MiB, WS_WDN = 21 * MiB, WS_LORA = 27 * MiB, WS_CS = 28 * MiB, WS_C2 = 32 * MiB, WS_ML = 34 * MiB,
                 WS_H = 43 * MiB, WS_Y = 172 * MiB, WS_A = 300 * MiB, WS_Z = 556 * MiB, WS_END = 974 * MiB;
constexpr int LDS_RING = 131072, LDS_X = 131072, LDS_MISC = 147456, LDS_BYTES = 148480;

__device__ __forceinline__ unsigned pk2(float lo, float hi) { return pg8::cvt_pk_bf16(lo, hi); }
__device__ __forceinline__ float bf2f(unsigned short b) { return __builtin_bit_cast(float, (unsigned)b << 16); }
__device__ __forceinline__ float bflo(unsigned w) { return __builtin_bit_cast(float, w << 16); }
__device__ __forceinline__ float bfhi(unsigned w) { return __builtin_bit_cast(float, w & 0xffff0000u); }
template <int CTRL> __device__ __forceinline__ float dpp(float x) { return pg8::dppf<CTRL>(x); }
__device__ __forceinline__ float red16(float v) { v += dpp<0xB1>(v); v += dpp<0x4E>(v); v += dpp<0x141>(v); v += dpp<0x128>(v); return v; }
__device__ __forceinline__ float wave_sum(float v) {
#pragma unroll
    for (int o = 1; o < 64; o <<= 1) v += __shfl_xor(v, o);
    return v;
}
__device__ __forceinline__ float swap32_max(float m) { float a = m, b = m; asm volatile("s_nop 1\n\tv_permlane32_swap_b32 %0, %1\n\ts_nop 1" : "+v"(a), "+v"(b)); return fmaxf(a, b); }
__device__ __forceinline__ float swap32_sum(float m) { float a = m, b = m; asm volatile("s_nop 1\n\tv_permlane32_swap_b32 %0, %1\n\ts_nop 1" : "+v"(a), "+v"(b)); return a + b; }
__device__ __forceinline__ float fast_exp(float x) { return __builtin_amdgcn_exp2f(x * LOG2E); }
__device__ __forceinline__ float fast_sigmoid(float x) { return __builtin_amdgcn_rcpf(1.0f + fast_exp(-x)); }
__device__ __forceinline__ float fast_tanh(float x) { return 1.0f - 2.0f * __builtin_amdgcn_rcpf(1.0f + fast_exp(2.0f * x)); }
__device__ __forceinline__ float log1p_small(float e) { return e < 0.01f ? e * (1.0f - e * (0.5f - e * (1.0f / 3.0f))) : __logf(1.0f + e); }
__device__ __forceinline__ float softplusf(float y) { return fmaxf(y, 0.f) + log1p_small(fast_exp(-fabsf(y))); }
__device__ __forceinline__ int crow(int r, int hi) { return (r & 3) + 8 * (r >> 2) + 4 * hi; }
__device__ __forceinline__ s4v vtr(const LAS unsigned char* p) { return __builtin_bit_cast(s4v, __builtin_amdgcn_ds_read_tr16_b64_v4i16((LAS s4v*)p)); }

struct Args {
    const float* in[26]; float* out; unsigned char* ws; float inv_freq[8];
};

struct MapId { int n; __device__ __forceinline__ int operator()(int r) const { return r < n ? r : -1; } };
struct MapEvenIn { __device__ __forceinline__ int operator()(int r) const { return r < 1536 ? r : (r < 3328 ? r + 8 : (r < 3336 ? 1536 + (r - 3328) : -1)); } };
struct MapOddIn { __device__ __forceinline__ int operator()(int r) const { if (r >= 2048) return r; const int p = r & 63; return p < 16 ? (r & ~63) + (p >> 1) + 8 * (p & 1) : r; } };
struct MapUp { __device__ __forceinline__ int operator()(int r) const { const int pn = r >> 8, bj = (r >> 7) & 1, c = r & 127; return bj * 2816 + pn * 128 + c; } };
template <class Map> __device__ __forceinline__ void tr_convert(const float* W, int K, int N, bf16* WT, int Nout, const Map src, LAS float* scr, int gw, int NGW, int lane) {
    const int nblk = Nout / 32, items = (K / 64) * nblk;
    for (int it = gw; it < items; it += NGW) {
        const int kb = it / nblk, nb = it % nblk, k0 = 64 * kb, n0 = 32 * nb;
        const int sc = src(n0 + (lane & 31));
#pragma unroll 8
        for (int i = 0; i < 32; ++i) { const int kk = 2 * i + (lane >> 5); scr[kk * 33 + (lane & 31)] = sc >= 0 ? __builtin_nontemporal_load(W + (size_t)(k0 + kk) * N + sc) : 0.f; }
        asm volatile("s_waitcnt lgkmcnt(0)" ::: "memory");
        const int c = lane & 7;
#pragma unroll
        for (int j = 0; j < 4; ++j) { const int n = (lane >> 3) + 8 * j; const LAS float* s = scr + (8 * c) * 33 + n;
            u4 o; o.x = pk2(s[0 * 33], s[1 * 33]); o.y = pk2(s[2 * 33], s[3 * 33]); o.z = pk2(s[4 * 33], s[5 * 33]); o.w = pk2(s[6 * 33], s[7 * 33]);
            *(u4*)(WT + (size_t)(n0 + n) * K + k0 + 8 * c) = o; }
        asm volatile("s_waitcnt lgkmcnt(0)" ::: "memory");
    }
}
template <class AT> __device__ __forceinline__ void convert_layer_weights(const AT& A, int layer, LAS unsigned char* lds, int gw, int NGW, int wave, int lane) {
    LAS float* scr = (LAS float*)(lds + wave * 16384);
    unsigned char* ws = A.ws; const int i = layer >> 1;
    if ((layer & 1) == 0) {
        tr_convert(A.in[6] + (size_t)i * 1024 * 3336, 1024, 3336, (bf16*)(ws + WS_WIN), 3584, MapEvenIn{}, scr, gw, NGW, lane);
        tr_convert(A.in[19] + (size_t)i * 1024 * 1024, 1024, 1024, (bf16*)(ws + WS_WOUT), 1024, MapId{1024}, scr, gw, NGW, lane);
        tr_convert(A.in[10] + (size_t)i * 64 * 512, 64, 512, (bf16*)(ws + WS_LORA), 512, MapId{512}, scr, gw, NGW, lane);
        tr_convert(A.in[12] + (size_t)i * 64 * 512, 64, 512, (bf16*)(ws + WS_LORA + 65536), 512, MapId{512}, scr, gw, NGW, lane);
        tr_convert(A.in[13] + (size_t)i * 128 * 512, 128, 512, (bf16*)(ws + WS_LORA + 131072), 512, MapId{512}, scr, gw, NGW, lane);
    } else {
        tr_convert(A.in[20] + (size_t)i * 1024 * 3072, 1024, 3072, (bf16*)(ws + WS_WIN), 3072, MapOddIn{}, scr, gw, NGW, lane);
        tr_convert(A.in[21] + (size_t)i * 1024 * 1024, 1024, 1024, (bf16*)(ws + WS_WOUT), 1024, MapId{1024}, scr, gw, NGW, lane);
    }
    tr_convert(A.in[22] + (size_t)layer * 1024 * 5632, 1024, 5632, (bf16*)(ws + WS_WUP), 5632, MapUp{}, scr, gw, NGW, lane);
    tr_convert(A.in[25] + (size_t)layer * 2816 * 1024, 2816, 1024, (bf16*)(ws + WS_WDN), 1024, MapId{1024}, scr, gw, NGW, lane);
}

__device__ __forceinline__ void row_phase(const float* xsrc, const bf16* mbuf, const float* gpost, float* xout, const float* gpre, bf16* hout, int gw, int NGW, int lane) {
    f4 gp[4], gq[4];
#pragma unroll
    for (int j = 0; j < 4; ++j) { gp[j] = mbuf ? *(const f4*)(gpost + 4 * lane + 256 * j) : (f4){0.f, 0.f, 0.f, 0.f}; gq[j] = hout ? *(const f4*)(gpre + 4 * lane + 256 * j) : (f4){0.f, 0.f, 0.f, 0.f}; }
    for (int row = gw; row < M; row += NGW) {
        f4 x[4];
#pragma unroll
        for (int j = 0; j < 4; ++j) x[j] = __builtin_nontemporal_load((const f4*)(xsrc + (size_t)row * D + 4 * lane + 256 * j));
        if (mbuf) {
            f4 mv[4]; float ss = 0.f;
#pragma unroll
            for (int j = 0; j < 4; ++j) { const u2 mw = __builtin_nontemporal_load((const u2*)(mbuf + (size_t)row * D + 4 * lane + 256 * j)); mv[j] = (f4){bflo(mw.x), bfhi(mw.x), bflo(mw.y), bfhi(mw.y)}; ss += (mv[j].x * mv[j].x + mv[j].y * mv[j].y) + (mv[j].z * mv[j].z + mv[j].w * mv[j].w); }
            const float rs = __builtin_amdgcn_rsqf(wave_sum(ss) * (1.0f / D) + RMS_EPS);
#pragma unroll
            for (int j = 0; j < 4; ++j) x[j] = x[j] + mv[j] * rs * gp[j];
        }
        if (xout) {
#pragma unroll
            for (int j = 0; j < 4; ++j) __builtin_nontemporal_store(x[j], (f4*)(xout + (size_t)row * D + 4 * lane + 256 * j));
        }
        if (hout) {
            float ss = 0.f;
#pragma unroll
            for (int j = 0; j < 4; ++j) ss += (x[j].x * x[j].x + x[j].y * x[j].y) + (x[j].z * x[j].z + x[j].w * x[j].w);
            const float rs = __builtin_amdgcn_rsqf(wave_sum(ss) * (1.0f / D) + RMS_EPS);
#pragma unroll
            for (int j = 0; j < 4; ++j) { const f4 o = x[j] * rs * gq[j]; u2 w; w.x = pk2(o.x, o.y); w.y = pk2(o.z, o.w); *(u2*)(hout + (size_t)row * D + 4 * lane + 256 * j) = w; }
        }
    }
}

struct AttnP {
    const bf16 *q, *k, *v; int ld;
    int stride, resid;
    int qi0, kbase, jt0, jt1, W;
    float kmax;
    const float* c2;
    bf16* oacc; float* ml;
    int load_state, final;
    bf16* y;
};
constexpr int ATT_BUFB = 43520;
template <bool FOX> __device__ __forceinline__ void attn_unit(const AttnP& P, LAS unsigned char* lds, int tid, int wave, int lane) {
    __syncthreads();
    const int r32 = lane & 31, hi = lane >> 5;
    const int wq0 = P.qi0 + wave * 32, iq = wq0 + r32;
    const long qtok = (long)iq * P.stride + P.resid;
    s8 qf[4];
#pragma unroll
    for (int ds = 0; ds < 4; ++ds) qf[ds] = *(const s8*)(P.q + qtok * P.ld + ds * 16 + hi * 8);
    float cq2 = 0.f; if (FOX) cq2 = P.c2[qtok * 8];
    float qbound = 0.f;
    if (FOX) { float qs = 0.f;
#pragma unroll
        for (int ds = 0; ds < 4; ++ds) { const u4 w = __builtin_bit_cast(u4, qf[ds]); const unsigned ww[4] = {w.x, w.y, w.z, w.w};
#pragma unroll
            for (int k = 0; k < 4; ++k) { const float lo = bflo(ww[k]), hh = bfhi(ww[k]); qs += lo * lo + hh * hh; } }
        qs = swap32_sum(qs); qbound = sqrtf(qs) * SCL * P.kmax * 1.001f + 1.0f; }
    LAS int* cntw = (LAS int*)(lds + LDS_MISC + 256);
    if (FOX && tid < 64) cntw[tid] = 0;
    bool wdone = false, first = true; float cbase = cq2;
    f16v o0, o1; float mrun = FOX ? 0.f : -1e30f, lsum = 0.f;
#pragma unroll
    for (int r = 0; r < 16; ++r) { o0[r] = 0.f; o1[r] = 0.f; }
    if (P.load_state) {
        const bf16* op = P.oacc + qtok * 1024 + 4 * hi;
#pragma unroll
        for (int rg = 0; rg < 4; ++rg) { const u2 aw = *(const u2*)(op + 8 * rg), bw = *(const u2*)(op + 32 + 8 * rg);
            o0[4 * rg] = bflo(aw.x); o0[4 * rg + 1] = bfhi(aw.x); o0[4 * rg + 2] = bflo(aw.y); o0[4 * rg + 3] = bfhi(aw.y);
            o1[4 * rg] = bflo(bw.x); o1[4 * rg + 1] = bfhi(bw.x); o1[4 * rg + 2] = bflo(bw.y); o1[4 * rg + 3] = bfhi(bw.y); }
        mrun = P.ml[qtok * 32]; lsum = (hi == 0) ? P.ml[qtok * 32 + 1] : 0.f;
    }
    int jlo = (wq0 - P.W - P.kbase) >> 6; if (jlo < P.jt0) jlo = P.jt0;
    int jhi = (wq0 + 31 - P.kbase) >> 6; if (jhi > P.jt1 - 1) jhi = P.jt1 - 1;
    const int lrow = tid >> 3, lch = tid & 7;
    u4 kreg0, vreg0, kreg1, vreg1; float creg = 0.f;
#define ATT_LOAD(jd) do { const long ktok_ = (long)(P.kbase + 128 * (jd) + lrow) * P.stride + P.resid; const long kstep_ = 64L * P.stride * P.ld; \
        const bf16* kp_ = P.k + ktok_ * P.ld + lch * 8; const bf16* vp_ = P.v + ktok_ * P.ld + lch * 8; \
        kreg0 = *(const u4*)kp_; vreg0 = *(const u4*)vp_; kreg1 = *(const u4*)(kp_ + kstep_); vreg1 = *(const u4*)(vp_ + kstep_); \
        if (FOX && tid < 128) { const long ct_ = (long)(P.kbase + 128 * (jd) + tid) * P.stride + P.resid; creg = P.c2[ct_ * 8]; } } while (0)
#define ATT_STORE(bb) do { LAS unsigned char* b_ = lds + (bb) * ATT_BUFB; \
        *(LAS u4*)(b_ + lrow * 144 + lch * 16) = kreg0; *(LAS u4*)(b_ + (lrow + 64) * 144 + lch * 16) = kreg1; \
        *(LAS u4*)(b_ + 18432 + lrow * 192 + lch * 16) = vreg0; *(LAS u4*)(b_ + 18432 + (lrow + 64) * 192 + lch * 16) = vreg1; \
        if (FOX && tid < 128) *(LAS float*)(b_ + 43008 + tid * 4) = creg; } while (0)
    const int jd0 = P.jt0 >> 1, jd1 = P.jt1 >> 1;
    const int jdir = FOX ? -1 : 1, jfirst = FOX ? jd1 - 1 : jd0, nj = jd1 - jd0;
    ATT_LOAD(jfirst); ATT_STORE(0); __syncthreads();
    const int g16 = lane >> 4, i16 = lane & 15;
    const int vlane_off = (4 * hi + (i16 >> 2)) * 192 + (16 * (g16 & 1) + 4 * (i16 & 3)) * 2;
    for (int ji = 0; ji < nj; ++ji) {
        const int jd = jfirst + jdir * ji;
        const int bsel = ji & 1;
        if (ji + 1 < nj) ATT_LOAD(jd + jdir);
        if constexpr (FOX) {
        if (2 * jd <= jhi) {
            const LAS unsigned char* Kb = lds + bsel * ATT_BUFB; const LAS unsigned char* Vb = lds + bsel * ATT_BUFB + 18432;
            const LAS float* ckb = (const LAS float*)(lds + bsel * ATT_BUFB + 43008);
            f16v sc[4];
#pragma unroll
            for (int t4 = 0; t4 < 4; ++t4)
#pragma unroll
                for (int r = 0; r < 16; ++r) sc[t4][r] = 0.f;
#pragma unroll
            for (int ds = 0; ds < 4; ++ds)
#pragma unroll
                for (int t4 = 0; t4 < 4; ++t4) {
                    const s8 kf = *(const LAS s8*)(Kb + (32 * t4 + r32) * 144 + (ds * 16 + hi * 8) * 2);
                    sc[t4] = __builtin_amdgcn_mfma_f32_32x32x16_bf16(kf, qf[ds], sc[t4], 0, 0, 0);
                }
            const int kv0 = P.kbase + 128 * jd;
            const bool need_mask = (kv0 + 127 > wq0);
#pragma unroll
            for (int t4 = 0; t4 < 4; ++t4)
#pragma unroll
                for (int rg = 0; rg < 4; ++rg) {
                    const f4 c0 = *(const LAS f4*)(ckb + 32 * t4 + 8 * rg + 4 * hi);
#pragma unroll
                    for (int j = 0; j < 4; ++j) { const int r = 4 * rg + j;
                        float x0 = sc[t4][r] * SCL + (cbase - c0[j]);
                        if (need_mask) { const int kj = kv0 + 32 * t4 + crow(r, hi); if (kj > iq) x0 = -1e30f; }
                        sc[t4][r] = x0; }
                }
            float mx = fmaxf(fmaxf(sc[0][0], sc[1][0]), fmaxf(sc[2][0], sc[3][0]));
#pragma unroll
            for (int r = 1; r < 16; ++r) mx = fmaxf(mx, fmaxf(fmaxf(sc[0][r], sc[1][r]), fmaxf(sc[2][r], sc[3][r])));
            mx = swap32_max(mx);
            if (__any(first || mx > -160.0f)) {
            const float delta = (first || mx > 8.0f) ? mx : 0.f;
            if (__any(delta != 0.f)) {
                const float alpha = first ? 0.f : __builtin_amdgcn_exp2f(-delta);
                lsum *= alpha;
#pragma unroll
                for (int r = 0; r < 16; ++r) { o0[r] *= alpha; o1[r] *= alpha; }
#pragma unroll
                for (int t4 = 0; t4 < 4; ++t4)
#pragma unroll
                    for (int r = 0; r < 16; ++r) sc[t4][r] -= delta;
                mrun += delta; cbase -= delta;
            }
            first = false;
            float ps = 0.f;
#pragma unroll
            for (int t4 = 0; t4 < 4; ++t4)
#pragma unroll
                for (int r = 0; r < 16; ++r) { sc[t4][r] = __builtin_amdgcn_exp2f(sc[t4][r]); ps += sc[t4][r]; }
            lsum += ps;
#pragma unroll
            for (int t4 = 0; t4 < 4; ++t4)
#pragma unroll
                for (int s = 0; s < 2; ++s) {
                    const u4 pw = (u4){pk2(sc[t4][8 * s + 0], sc[t4][8 * s + 1]), pk2(sc[t4][8 * s + 2], sc[t4][8 * s + 3]), pk2(sc[t4][8 * s + 4], sc[t4][8 * s + 5]), pk2(sc[t4][8 * s + 6], sc[t4][8 * s + 7])};
                    const LAS unsigned char* vp = Vb + (32 * t4 + 16 * s) * 192 + vlane_off;
                    const s4v a0 = vtr(vp), a1 = vtr(vp + 8 * 192), b0 = vtr(vp + 64), b1 = vtr(vp + 8 * 192 + 64);
                    const s8 vf0 = (s8){a0[0], a0[1], a0[2], a0[3], a1[0], a1[1], a1[2], a1[3]};
                    const s8 vf1 = (s8){b0[0], b0[1], b0[2], b0[3], b1[0], b1[1], b1[2], b1[3]};
                    const s8 pb = __builtin_bit_cast(s8, pw);
                    o0 = __builtin_amdgcn_mfma_f32_32x32x16_bf16(vf0, pb, o0, 0, 0, 0);
                    o1 = __builtin_amdgcn_mfma_f32_32x32x16_bf16(vf1, pb, o1, 0, 0, 0);
                }
            }
            if (!wdone && __all((qbound + (cbase - ckb[0]) < -160.0f) && !first)) wdone = true;
        }
        if (wdone && lane == 0) atomicAdd((int*)&cntw[ji], 1);
        } else {
#pragma unroll
        for (int sub = 0; sub < 2; ++sub) {
        const int jt = 2 * jd + sub;
        if (jt >= jlo && jt <= jhi) {
            const LAS unsigned char* Kb = lds + bsel * ATT_BUFB + sub * (64 * 144); const LAS unsigned char* Vb = lds + bsel * ATT_BUFB + 18432 + sub * (64 * 192);
            const LAS float* ckb = (const LAS float*)(lds + bsel * ATT_BUFB + 43008) + sub * 64;
            f16v s0, s1;
#pragma unroll
            for (int r = 0; r < 16; ++r) { s0[r] = 0.f; s1[r] = 0.f; }
#pragma unroll
            for (int ds = 0; ds < 4; ++ds) {
                const s8 k0 = *(const LAS s8*)(Kb + r32 * 144 + (ds * 16 + hi * 8) * 2);
                const s8 k1 = *(const LAS s8*)(Kb + (32 + r32) * 144 + (ds * 16 + hi * 8) * 2);
                s0 = __builtin_amdgcn_mfma_f32_32x32x16_bf16(k0, qf[ds], s0, 0, 0, 0);
                s1 = __builtin_amdgcn_mfma_f32_32x32x16_bf16(k1, qf[ds], s1, 0, 0, 0);
            }
            const int kv0 = P.kbase + 64 * jt;
            const bool need_mask = (kv0 + 63 > wq0) || (kv0 < wq0 + 31 - P.W);
#pragma unroll
            for (int rg = 0; rg < 4; ++rg) {
                f4 c0 = (f4){0.f, 0.f, 0.f, 0.f}, c1 = c0;
                if (FOX) { c0 = *(const LAS f4*)(ckb + 8 * rg + 4 * hi); c1 = *(const LAS f4*)(ckb + 32 + 8 * rg + 4 * hi); }
#pragma unroll
                for (int j = 0; j < 4; ++j) { const int r = 4 * rg + j;
                    float x0 = s0[r] * SCL, x1 = s1[r] * SCL;
                    if (FOX) { x0 += cq2 - c0[j]; x1 += cq2 - c1[j]; }
                    if (need_mask) { const int kj = kv0 + crow(r, hi); if (kj > iq || kj < iq - P.W) x0 = -1e30f; if (kj + 32 > iq || kj + 32 < iq - P.W) x1 = -1e30f; }
                    s0[r] = x0; s1[r] = x1; }
            }
            float mx = fmaxf(s0[0], s1[0]);
#pragma unroll
            for (int r = 1; r < 16; ++r) mx = fmaxf(mx, fmaxf(s0[r], s1[r]));
            mx = swap32_max(mx);
            const float mnew = (mx > mrun + 8.0f) ? mx : mrun;
            if (__any(mnew != mrun)) {
                const float alpha = __builtin_amdgcn_exp2f(mrun - mnew);
                lsum *= alpha;
#pragma unroll
                for (int r = 0; r < 16; ++r) { o0[r] *= alpha; o1[r] *= alpha; }
            }
            mrun = mnew;
            float ps = 0.f;
#pragma unroll
            for (int r = 0; r < 16; ++r) { s0[r] = __builtin_amdgcn_exp2f(s0[r] - mnew); s1[r] = __builtin_amdgcn_exp2f(s1[r] - mnew); ps += s0[r] + s1[r]; }
            lsum += ps;
            u4 pf[2][2];
#pragma unroll
            for (int s = 0; s < 2; ++s) {
                pf[0][s] = (u4){pk2(s0[8 * s + 0], s0[8 * s + 1]), pk2(s0[8 * s + 2], s0[8 * s + 3]), pk2(s0[8 * s + 4], s0[8 * s + 5]), pk2(s0[8 * s + 6], s0[8 * s + 7])};
                pf[1][s] = (u4){pk2(s1[8 * s + 0], s1[8 * s + 1]), pk2(s1[8 * s + 2], s1[8 * s + 3]), pk2(s1[8 * s + 4], s1[8 * s + 5]), pk2(s1[8 * s + 6], s1[8 * s + 7])};
            }
#pragma unroll
            for (int kt = 0; kt < 2; ++kt)
#pragma unroll
                for (int s = 0; s < 2; ++s) {
                    const LAS unsigned char* vp = Vb + (32 * kt + 16 * s) * 192 + vlane_off;
                    const s4v a0 = vtr(vp), a1 = vtr(vp + 8 * 192), b0 = vtr(vp + 64), b1 = vtr(vp + 8 * 192 + 64);
                    const s8 vf0 = (s8){a0[0], a0[1], a0[2], a0[3], a1[0], a1[1], a1[2], a1[3]};
                    const s8 vf1 = (s8){b0[0], b0[1], b0[2], b0[3], b1[0], b1[1], b1[2], b1[3]};
                    const s8 pb = __builtin_bit_cast(s8, pf[kt][s]);
                    o0 = __builtin_amdgcn_mfma_f32_32x32x16_bf16(vf0, pb, o0, 0, 0, 0);
                    o1 = __builtin_amdgcn_mfma_f32_32x32x16_bf16(vf1, pb, o1, 0, 0, 0);
                }
        }
        }
        }
        if (ji + 1 < nj) ATT_STORE(bsel ^ 1);
        __syncthreads();
        if (FOX) { if (cntw[ji] == NWAVES) break; }
    }
#undef ATT_LOAD
#undef ATT_STORE
    const float ltot = swap32_sum(lsum);
    if (!P.final) {
        bf16* op = P.oacc + qtok * 1024 + 4 * hi;
#pragma unroll
        for (int rg = 0; rg < 4; ++rg) { u2 aw, bw; aw.x = pk2(o0[4 * rg], o0[4 * rg + 1]); aw.y = pk2(o0[4 * rg + 2], o0[4 * rg + 3]); bw.x = pk2(o1[4 * rg], o1[4 * rg + 1]); bw.y = pk2(o1[4 * rg + 2], o1[4 * rg + 3]);
            *(u2*)(op + 8 * rg) = aw; *(u2*)(op + 32 + 8 * rg) = bw; }
        if (hi == 0) { P.ml[qtok * 32] = mrun; P.ml[qtok * 32 + 1] = ltot; }
    } else {
        const float inv = 1.0f / ltot;
        bf16* yp = P.y + qtok * 1024 + 4 * hi;
#pragma unroll
        for (int rg = 0; rg < 4; ++rg) {
            u2 w0, w1; w0.x = pk2(o0[4 * rg] * inv, o0[4 * rg + 1] * inv); w0.y = pk2(o0[4 * rg + 2] * inv, o0[4 * rg + 3] * inv);
            w1.x = pk2(o1[4 * rg] * inv, o1[4 * rg + 1] * inv); w1.y = pk2(o1[4 * rg + 2] * inv, o1[4 * rg + 3] * inv);
            *(u2*)(yp + 8 * rg) = w0; *(u2*)(yp + 32 + 8 * rg) = w1;
        }
    }
}

__device__ __forceinline__ void attn_band_unit(const AttnP& P, LAS unsigned char* lds, int tid, int wave, int lane) {
    __syncthreads();
    const int r32 = lane & 31, hi = lane >> 5;
    const int wq0 = P.qi0 + wave * 32, iq = wq0 + r32;
    const long qtok = (long)iq * P.stride + P.resid;
    s8 qf[4];
#pragma unroll
    for (int ds = 0; ds < 4; ++ds) qf[ds] = *(const s8*)(P.q + qtok * P.ld + ds * 16 + hi * 8);
    f16v o0, o1; float mrun = -1e30f, lsum = 0.f;
#pragma unroll
    for (int r = 0; r < 16; ++r) { o0[r] = 0.f; o1[r] = 0.f; }
    if (P.load_state) {
        const bf16* op = P.oacc + qtok * 1024 + 4 * hi;
#pragma unroll
        for (int rg = 0; rg < 4; ++rg) { const u2 aw = *(const u2*)(op + 8 * rg), bw = *(const u2*)(op + 32 + 8 * rg);
            o0[4 * rg] = bflo(aw.x); o0[4 * rg + 1] = bfhi(aw.x); o0[4 * rg + 2] = bflo(aw.y); o0[4 * rg + 3] = bfhi(aw.y);
            o1[4 * rg] = bflo(bw.x); o1[4 * rg + 1] = bfhi(bw.x); o1[4 * rg + 2] = bflo(bw.y); o1[4 * rg + 3] = bfhi(bw.y); }
        mrun = P.ml[qtok * 32]; lsum = (hi == 0) ? P.ml[qtok * 32 + 1] : 0.f;
    }
    int jlo = (wq0 - P.W - P.kbase) >> 6; if (jlo < P.jt0) jlo = P.jt0;
    int jhi = (wq0 + 31 - P.kbase) >> 6; if (jhi > P.jt1 - 1) jhi = P.jt1 - 1;
    {
        const int lrow = tid >> 3, lch = tid & 7;
#pragma unroll
        for (int hf = 0; hf < 2; ++hf) {
            u4 kr[3], vr[3];
#pragma unroll
            for (int q = 0; q < 3; ++q) { int kidx = P.kbase + lrow + 64 * (3 * hf + q); if (kidx < 0) kidx = 0; const long ktok = (long)kidx * P.stride + P.resid;
                kr[q] = *(const u4*)(P.k + ktok * P.ld + lch * 8); vr[q] = *(const u4*)(P.v + ktok * P.ld + lch * 8); }
#pragma unroll
            for (int q = 0; q < 3; ++q) { const int row = lrow + 64 * (3 * hf + q);
                *(LAS u4*)(lds + row * 144 + lch * 16) = kr[q]; *(LAS u4*)(lds + 55296 + row * 192 + lch * 16) = vr[q]; }
        }
    }
    __syncthreads();
    const int g16 = lane >> 4, i16 = lane & 15;
    const int vlane_off = (4 * hi + (i16 >> 2)) * 192 + (16 * (g16 & 1) + 4 * (i16 & 3)) * 2;
#pragma unroll 1
    for (int jt = jlo; jt <= jhi; ++jt) {
        {
            const LAS unsigned char* Kb = lds + jt * (64 * 144); const LAS unsigned char* Vb = lds + 55296 + jt * (64 * 192);
            f16v s0, s1;
#pragma unroll
            for (int r = 0; r < 16; ++r) { s0[r] = 0.f; s1[r] = 0.f; }
#pragma unroll
            for (int ds = 0; ds < 4; ++ds) {
                const s8 k0 = *(const LAS s8*)(Kb + r32 * 144 + (ds * 16 + hi * 8) * 2);
                const s8 k1 = *(const LAS s8*)(Kb + (32 + r32) * 144 + (ds * 16 + hi * 8) * 2);
                s0 = __builtin_amdgcn_mfma_f32_32x32x16_bf16(k0, qf[ds], s0, 0, 0, 0);
                s1 = __builtin_amdgcn_mfma_f32_32x32x16_bf16(k1, qf[ds], s1, 0, 0, 0);
            }
            const int kv0 = P.kbase + 64 * jt;
            const bool need_mask = (kv0 + 63 > wq0) || (kv0 < wq0 + 31 - P.W);
#pragma unroll
            for (int rg = 0; rg < 4; ++rg) {
#pragma unroll
                for (int j = 0; j < 4; ++j) { const int r = 4 * rg + j;
                    float x0 = s0[r] * SCL, x1 = s1[r] * SCL;
                    if (need_mask) { const int kj = kv0 + crow(r, hi); if (kj > iq || kj < iq - P.W) x0 = -1e30f; if (kj + 32 > iq || kj + 32 < iq - P.W) x1 = -1e30f; }
                    s0[r] = x0; s1[r] = x1; }
            }
            float mx = fmaxf(s0[0], s1[0]);
#pragma unroll
            for (int r = 1; r < 16; ++r) mx = fmaxf(mx, fmaxf(s0[r], s1[r]));
            mx = swap32_max(mx);
            const float mnew = (mx > mrun + 8.0f) ? mx : mrun;
            if (__any(mnew != mrun)) {
                const float alpha = __builtin_amdgcn_exp2f(mrun - mnew);
                lsum *= alpha;
#pragma unroll
                for (int r = 0; r < 16; ++r) { o0[r] *= alpha; o1[r] *= alpha; }
            }
            mrun = mnew;
            float ps = 0.f;
#pragma unroll
            for (int r = 0; r < 16; ++r) { s0[r] = __builtin_amdgcn_exp2f(s0[r] - mnew); s1[r] = __builtin_amdgcn_exp2f(s1[r] - mnew); ps += s0[r] + s1[r]; }
            lsum += ps;
            u4 pf[2][2];
#pragma unroll
            for (int s = 0; s < 2; ++s) {
                pf[0][s] = (u4){pk2(s0[8 * s + 0], s0[8 * s + 1]), pk2(s0[8 * s + 2], s0[8 * s + 3]), pk2(s0[8 * s + 4], s0[8 * s + 5]), pk2(s0[8 * s + 6], s0[8 * s + 7])};
                pf[1][s] = (u4){pk2(s1[8 * s + 0], s1[8 * s + 1]), pk2(s1[8 * s + 2], s1[8 * s + 3]), pk2(s1[8 * s + 4], s1[8 * s + 5]), pk2(s1[8 * s + 6], s1[8 * s + 7])};
            }
#pragma unroll
            for (int kt = 0; kt < 2; ++kt)
#pragma unroll
                for (int s = 0; s < 2; ++s) {
                    const LAS unsigned char* vp = Vb + (32 * kt + 16 * s) * 192 + vlane_off;
                    const s4v a0 = vtr(vp), a1 = vtr(vp + 8 * 192), b0 = vtr(vp + 64), b1 = vtr(vp + 8 * 192 + 64);
                    const s8 vf0 = (s8){a0[0], a0[1], a0[2], a0[3], a1[0], a1[1], a1[2], a1[3]};
                    const s8 vf1 = (s8){b0[0], b0[1], b0[2], b0[3], b1[0], b1[1], b1[2], b1[3]};
                    const s8 pb = __builtin_bit_cast(s8, pf[kt][s]);
                    o0 = __builtin_amdgcn_mfma_f32_32x32x16_bf16(vf0, pb, o0, 0, 0, 0);
                    o1 = __builtin_amdgcn_mfma_f32_32x32x16_bf16(vf1, pb, o1, 0, 0, 0);
                }
        }
    }
    const float ltot = swap32_sum(lsum);
    if (!P.final) {
        bf16* op = P.oacc + qtok * 1024 + 4 * hi;
#pragma unroll
        for (int rg = 0; rg < 4; ++rg) { u2 aw, bw; aw.x = pk2(o0[4 * rg], o0[4 * rg + 1]); aw.y = pk2(o0[4 * rg + 2], o0[4 * rg + 3]); bw.x = pk2(o1[4 * rg], o1[4 * rg + 1]); bw.y = pk2(o1[4 * rg + 2], o1[4 * rg + 3]);
            *(u2*)(op + 8 * rg) = aw; *(u2*)(op + 32 + 8 * rg) = bw; }
        if (hi == 0) { P.ml[qtok * 32] = mrun; P.ml[qtok * 32 + 1] = ltot; }
    } else {
        const float inv = 1.0f / ltot;
        bf16* yp = P.y + qtok * 1024 + 4 * hi;
#pragma unroll
        for (int rg = 0; rg < 4; ++rg) {
            u2 w0, w1; w0.x = pk2(o0[4 * rg] * inv, o0[4 * rg + 1] * inv); w0.y = pk2(o0[4 * rg + 2] * inv, o0[4 * rg + 3] * inv);
            w1.x = pk2(o1[4 * rg] * inv, o1[4 * rg + 1] * inv); w1.y = pk2(o1[4 * rg + 2] * inv, o1[4 * rg + 3] * inv);
            *(u2*)(yp + 8 * rg) = w0; *(u2*)(yp + 32 + 8 * rg) = w1;
        }
    }
}

__device__ __forceinline__ void fox_kmax(unsigned char* ws, int i, int gw, int NGW, int lane) {
    const bf16* z = (const bf16*)(ws + WS_Z);
    const int r32 = lane & 31, hi = lane >> 5;
    for (int job = gw; job < M / 32; job += NGW) {
        const int tok0 = 32 * job; const bf16* zr = z + (size_t)(tok0 + r32) * ZE_LD;
        unsigned* kmax2 = (unsigned*)(ws + WS_CTL) + 256 + 64 * i + (tok0 >> 13) * 8;
#pragma unroll 1
        for (int hh = 0; hh < 4; ++hh) { const int h = 4 * hi + hh; float s = 0.f;
#pragma unroll
            for (int q = 0; q < 8; ++q) { const u4 w = *(const u4*)(zr + 512 + 64 * h + 8 * q); const unsigned ww[4] = {w.x, w.y, w.z, w.w};
#pragma unroll
                for (int k = 0; k < 4; ++k) { const float lo = bflo(ww[k]), hv = bfhi(ww[k]); s += lo * lo + hv * hv; } }
            s = fmaxf(s, dpp<0xB1>(s)); s = fmaxf(s, dpp<0x4E>(s)); s = fmaxf(s, dpp<0x141>(s)); s = fmaxf(s, dpp<0x128>(s));
            if ((lane & 15) == 0) atomicMax(kmax2 + h, __builtin_bit_cast(unsigned, s)); }
    }
}
__device__ __forceinline__ s8 lerp8(const bf16* cur, const bf16* prev, bool has_prev, const float* mu, int act) {
    const u4 c = *(const u4*)cur; u4 p = (u4){0u, 0u, 0u, 0u}; if (has_prev) p = *(const u4*)prev;
    const f4 m0 = *(const f4*)mu, m1 = *(const f4*)(mu + 4);
    float x[8];
    const unsigned cw[4] = {c.x, c.y, c.z, c.w}, pw[4] = {p.x, p.y, p.z, p.w};
#pragma unroll
    for (int i = 0; i < 4; ++i) { const float a = bflo(cw[i]), b = bfhi(cw[i]), pa = bflo(pw[i]), pb = bfhi(pw[i]);
        const float ma = (i < 2) ? m0[2 * i] : m1[2 * i - 4], mb = (i < 2) ? m0[2 * i + 1] : m1[2 * i - 3];
        x[2 * i] = a + (pa - a) * ma; x[2 * i + 1] = b + (pb - b) * mb; }
#pragma unroll
    for (int i = 0; i < 8; ++i) { if (act == 1) x[i] = fast_tanh(x[i]); else if (act == 2) x[i] = fast_sigmoid(x[i]); }
    const u4 o = (u4){pk2(x[0], x[1]), pk2(x[2], x[3]), pk2(x[4], x[5]), pk2(x[6], x[7])};
    return __builtin_bit_cast(s8, o);
}
template <class AT> __device__ __forceinline__ void rwkv_prep(const AT& A, int i, int gw, int NGW, int lane) {
    unsigned char* ws = A.ws;
    const bf16* z = (const bf16*)(ws + WS_Z);
    const bf16* w2t = (const bf16*)(ws + WS_LORA); const bf16* a2t = (const bf16*)(ws + WS_LORA + 65536); const bf16* g2t = (const bf16*)(ws + WS_LORA + 131072);
    bf16* Asig = (bf16*)(ws + WS_A); bf16* G = (bf16*)(ws + WS_A + 64 * MiB); float* Wl2 = (float*)(ws + WS_A + 128 * MiB);
    const float* mu = A.in[8] + (size_t)i * 1792; const float* w0 = A.in[9] + (size_t)i * 512; const float* a0 = A.in[11] + (size_t)i * 512;
    const int r32 = lane & 31, hi = lane >> 5;
    for (int job = gw; job < M / 32; job += NGW) {
        const int tok0 = 32 * job, tok = tok0 + r32; const bool hp = (tok & (T - 1)) != 0;
        const bf16* zr = z + (size_t)tok * ZE_LD; const bf16* zp = zr - ZE_LD;
#pragma unroll 1
        for (int which = 0; which < 3; ++which) {
            const int KS = (which == 2) ? 8 : 4;
            const int zc = (which == 0) ? 3072 : (which == 1 ? 3136 : 3200), mc = (which == 0) ? 1536 : (which == 1 ? 1600 : 1664);
            const bf16* wt = (which == 0) ? w2t : (which == 1 ? a2t : g2t); const int wld = (which == 2) ? 128 : 64;
            s8 Af[8];
#pragma unroll
            for (int ks = 0; ks < 8; ++ks) { if (ks < KS) { const int c = 16 * ks + 8 * hi; Af[ks] = lerp8(zr + zc + c, zp + zc + c, hp, mu + mc + c, which == 0 ? 1 : (which == 1 ? 0 : 2)); } else Af[ks] = Af[0]; }
#pragma unroll 1
            for (int nt = 0; nt < 16; ++nt) {
                const int n = 32 * nt + r32;
                f16v dd;
#pragma unroll
                for (int r = 0; r < 16; ++r) dd[r] = 0.f;
#pragma unroll
                for (int ks = 0; ks < 8; ++ks) { if (ks < KS) { const s8 bw = *(const s8*)(wt + (size_t)n * wld + 16 * ks + 8 * hi); dd = __builtin_amdgcn_mfma_f32_32x32x16_bf16(Af[ks], bw, dd, 0, 0, 0); } }
                const float c0n = (which == 0) ? w0[n] : (which == 1 ? a0[n] : 0.f);
#pragma unroll
                for (int r = 0; r < 16; ++r) {
                    const size_t o = (size_t)(tok0 + crow(r, hi)) * 512 + n;
                    if (which == 0) { const float wv = -softplusf(-(c0n + dd[r])) - 0.5f; Wl2[o] = -fast_exp(wv) * LOG2E; }
                    else if (which == 1) Asig[o] = (bf16)(pk2(fast_sigmoid(c0n + dd[r]), 0.f) & 0xffffu);
                    else G[o] = (bf16)(pk2(dd[r], 0.f) & 0xffffu);
                }
            }
        }
    }
}
template <class AT> __device__ __forceinline__ void fox_cumsum(const AT& A, int i, int b, LAS unsigned char* lds, int tid, int wave, int lane) {
    unsigned char* ws = A.ws;
    const bf16* z = (const bf16*)(ws + WS_Z) + (size_t)b * T * ZE_LD + 3328;
    float* c2 = (float*)(ws + WS_C2) + (size_t)b * T * 8;
    const float* bias = A.in[7] + i * 8;
    float bs[8];
#pragma unroll
    for (int h = 0; h < 8; ++h) bs[h] = bias[h];
    float acc[8];
#pragma unroll
    for (int h = 0; h < 8; ++h) acc[h] = 0.f;
    for (int t = 0; t < 16; ++t) {
        const u4 w = *(const u4*)(z + (size_t)(16 * tid + t) * ZE_LD);
        const unsigned ww[4] = {w.x, w.y, w.z, w.w};
#pragma unroll
        for (int k = 0; k < 4; ++k) { const float x0 = bflo(ww[k]) + bs[2 * k], x1 = bfhi(ww[k]) + bs[2 * k + 1]; acc[2 * k] += fminf(x0, 0.f) - log1p_small(fast_exp(-fabsf(x0))); acc[2 * k + 1] += fminf(x1, 0.f) - log1p_small(fast_exp(-fabsf(x1))); }
    }
    float inc[8];
#pragma unroll
    for (int h = 0; h < 8; ++h) { float v = acc[h];
#pragma unroll
        for (int o = 1; o < 64; o <<= 1) { const float u = __shfl_up(v, o); if (lane >= o) v += u; }
        inc[h] = v; }
    LAS float* tot = (LAS float*)lds;
    __syncthreads();
    if (lane == 63) {
#pragma unroll
        for (int h = 0; h < 8; ++h) tot[wave * 8 + h] = inc[h];
    }
    __syncthreads();
    float run[8];
#pragma unroll
    for (int h = 0; h < 8; ++h) { float p = 0.f; for (int w = 0; w < wave; ++w) p += tot[w * 8 + h]; run[h] = p + inc[h] - acc[h]; }
    for (int t = 0; t < 16; ++t) {
        const u4 w = *(const u4*)(z + (size_t)(16 * tid + t) * ZE_LD);
        const unsigned ww[4] = {w.x, w.y, w.z, w.w};
#pragma unroll
        for (int k = 0; k < 4; ++k) { const float x0 = bflo(ww[k]) + bs[2 * k], x1 = bfhi(ww[k]) + bs[2 * k + 1]; run[2 * k] += fminf(x0, 0.f) - log1p_small(fast_exp(-fabsf(x0))); run[2 * k + 1] += fminf(x1, 0.f) - log1p_small(fast_exp(-fabsf(x1))); }
        float* cp = c2 + (size_t)(16 * tid + t) * 8;
        *(f4*)cp = (f4){run[0] * LOG2E, run[1] * LOG2E, run[2] * LOG2E, run[3] * LOG2E};
        *(f4*)(cp + 4) = (f4){run[4] * LOG2E, run[5] * LOG2E, run[6] * LOG2E, run[7] * LOG2E};
    }
    __syncthreads();
}

__device__ __forceinline__ f4 bf4(u2 w) { return (f4){bflo(w.x), bfhi(w.x), bflo(w.y), bfhi(w.y)}; }
template <class AT> __device__ __forceinline__ void scan_job(const AT& A, int i, int b, int h, int half, LAS unsigned char* lds, int tid) {
    unsigned char* ws = A.ws;
    const int tt = tid >> 4, kg = tid & 15, rp = tid >> 4;
    const int hc = 64 * h + 4 * kg;
    const bf16* zb = (const bf16*)(ws + WS_Z) + (size_t)b * T * ZE_LD;
    const bf16* Asig = (const bf16*)(ws + WS_A) + (size_t)b * T * 512 + hc;
    const float* Wl2 = (const float*)(ws + WS_A + 128 * MiB) + (size_t)b * T * 512 + hc;
    bf16* Y = (bf16*)(ws + WS_Y) + (size_t)b * T * 1024 + 512 + 64 * h + 32 * half + 2 * kg;
    const float* mu = A.in[8] + (size_t)i * 1792;
    const f4 mu_r = *(const f4*)(mu + hc), mu_k = *(const f4*)(mu + 512 + hc), mu_v = *(const f4*)(mu + 1024 + hc);
    const f4 kk_k = *(const f4*)(A.in[14] + i * 512 + hc), k_a = *(const f4*)(A.in[15] + i * 512 + hc), r_k = *(const f4*)(A.in[16] + i * 512 + hc);
    float* BON = (float*)(ws + WS_ML) + (size_t)b * T * 8 + h;
    LAS float* Wd = (LAS float*)lds; LAS float* Av = Wd + 2048; LAS float* Bv = Av + 2048; LAS float* Kv = Bv + 2048; LAS float* Rv = Kv + 2048; LAS float* Vv = Rv + 2048; LAS float* Bon = Vv + 2048; LAS float* Yp = Bon + 64;
    f2 s0l = (f2){0.f, 0.f}, s0h = s0l, s1l = s0l, s1h = s0l;
    u2 zr, zk, zv, zrp, zkp, zvp, za; f4 wl;
#define SCAN_LOAD(c) do { const int t_ = 32 * (c) + tt; const bf16* zt_ = zb + (size_t)t_ * ZE_LD + hc; \
        zr = *(const u2*)(zt_ + 1536); zk = *(const u2*)(zt_ + 2048); zv = *(const u2*)(zt_ + 2560); \
        if (t_ > 0) { zrp = *(const u2*)(zt_ - ZE_LD + 1536); zkp = *(const u2*)(zt_ - ZE_LD + 2048); zvp = *(const u2*)(zt_ - ZE_LD + 2560); } else { zrp = zkp = zvp = (u2){0u, 0u}; } \
        za = *(const u2*)(Asig + (size_t)t_ * 512); wl = *(const f4*)(Wl2 + (size_t)t_ * 512); } while (0)
    __syncthreads();
    SCAN_LOAD(0);
#pragma unroll 1
    for (int c = 0; c < T / 32; ++c) {
        {
            const f4 rc = bf4(zr), kc = bf4(zk), vc = bf4(zv), rpv = bf4(zrp), kpv = bf4(zkp), vpv = bf4(zvp), av = bf4(za);
            const f4 r = rc + (rpv - rc) * mu_r, k = kc + (kpv - kc) * mu_k, v = vc + (vpv - vc) * mu_v;
            f4 kkv = k * kk_k;
            const float ss = red16((kkv.x * kkv.x + kkv.y * kkv.y) + (kkv.z * kkv.z + kkv.w * kkv.w));
            const float inv = __builtin_amdgcn_rsqf(fmaxf(ss, 1e-24f));
            kkv = kkv * inv;
            const f4 kp = k * (1.0f + (av - 1.0f) * k_a);
            const f4 rk = r * kp * r_k;
            const float bon = red16((rk.x + rk.y) + (rk.z + rk.w));
            const f4 wd = (f4){__builtin_amdgcn_exp2f(wl.x), __builtin_amdgcn_exp2f(wl.y), __builtin_amdgcn_exp2f(wl.z), __builtin_amdgcn_exp2f(wl.w)};
            *(LAS f4*)(Wd + tt * 64 + 4 * kg) = wd; *(LAS f4*)(Av + tt * 64 + 4 * kg) = -kkv; *(LAS f4*)(Bv + tt * 64 + 4 * kg) = kkv * av;
            *(LAS f4*)(Kv + tt * 64 + 4 * kg) = kp; *(LAS f4*)(Rv + tt * 64 + 4 * kg) = r; *(LAS f4*)(Vv + tt * 64 + 4 * kg) = v;
            if (kg == 0) Bon[tt] = bon;
        }
        __syncthreads();
        if (c + 1 < T / 32) SCAN_LOAD(c + 1);
        if (tid < 256) {
            const LAS float* pW = Wd + 4 * kg; const LAS float* pV = Vv + 32 * half + 2 * rp;
            f4 w4 = *(const LAS f4*)(pW), a4 = *(const LAS f4*)(pW + 2048), b4 = *(const LAS f4*)(pW + 4096), k4 = *(const LAS f4*)(pW + 6144), r4 = *(const LAS f4*)(pW + 8192); f2 v2 = *(const LAS f2*)(pV);
#pragma unroll 2
            for (int st = 0; st < 32; ++st) {
                const int sn = ((st + 1) & 31) * 64;
                const f4 w4n = *(const LAS f4*)(pW + sn), a4n = *(const LAS f4*)(pW + 2048 + sn), b4n = *(const LAS f4*)(pW + 4096 + sn), k4n = *(const LAS f4*)(pW + 6144 + sn), r4n = *(const LAS f4*)(pW + 8192 + sn); const f2 v2n = *(const LAS f2*)(pV + sn);
                const f2 a_lo = (f2){a4.x, a4.y}, a_hi = (f2){a4.z, a4.w}, w_lo = (f2){w4.x, w4.y}, w_hi = (f2){w4.z, w4.w}, b_lo = (f2){b4.x, b4.y}, b_hi = (f2){b4.z, b4.w};
                const f2 k_lo = (f2){k4.x, k4.y}, k_hi = (f2){k4.z, k4.w}, r_lo = (f2){r4.x, r4.y}, r_hi = (f2){r4.z, r4.w};
                f2 t0 = s0l * a_lo; t0 = s0h * a_hi + t0; f2 t1 = s1l * a_lo; t1 = s1h * a_hi + t1;
                float sa0 = t0.x + t0.y, sa1 = t1.x + t1.y;
                sa0 = red16(sa0); sa1 = red16(sa1);
                s0l = s0l * w_lo + (b_lo * sa0 + k_lo * v2.x); s0h = s0h * w_hi + (b_hi * sa0 + k_hi * v2.x);
                s1l = s1l * w_lo + (b_lo * sa1 + k_lo * v2.y); s1h = s1h * w_hi + (b_hi * sa1 + k_hi * v2.y);
                f2 u0 = s0l * r_lo; u0 = s0h * r_hi + u0; f2 u1 = s1l * r_lo; u1 = s1h * r_hi + u1;
                const float y0 = u0.x + u0.y, y1 = u1.x + u1.y;
                *(LAS f2*)(Yp + (st * 256 + tid) * 2) = (f2){y0, y1};
                w4 = w4n; a4 = a4n; b4 = b4n; k4 = k4n; r4 = r4n; v2 = v2n;
            }
        }
        __syncthreads();
        {
            const int t = 32 * c + tt;
            const LAS f4* yp = (const LAS f4*)(Yp + (tt * 256 + kg * 16) * 2);
            f4 acc4 = yp[0];
#pragma unroll
            for (int q = 1; q < 8; ++q) acc4 = acc4 + yp[q];
            const float y0 = acc4.x + acc4.z, y1 = acc4.y + acc4.w;
            *(unsigned*)(Y + (size_t)t * 1024) = pk2(y0, y1);
            if (half == 0 && kg == 8) BON[(size_t)t * 8] = Bon[tt];
        }
        __syncthreads();
    }
#undef SCAN_LOAD
}

template <class AT> __device__ __forceinline__ void rwkv_post(const AT& A, int i, int gtid, int NGT) {
    unsigned char* ws = A.ws;
    const bf16* Z = (const bf16*)(ws + WS_Z); const bf16* G = (const bf16*)(ws + WS_A + 64 * MiB); const float* BON = (const float*)(ws + WS_ML);
    bf16* Y = (bf16*)(ws + WS_Y);
    const float* mu = A.in[8] + (size_t)i * 1792;
    const int kg = gtid & 15;
    for (int p = gtid >> 4; p < M * 8; p += NGT >> 4) {
        const int tok = p >> 3, h = p & 7, hc = 64 * h + 4 * kg;
        const f4 lnw = *(const f4*)(A.in[17] + i * 512 + hc), lnb = *(const f4*)(A.in[18] + i * 512 + hc), mu_v = *(const f4*)(mu + 1024 + hc);
        bf16* yp = Y + (size_t)tok * 1024 + 512 + hc;
        const f4 yv = bf4(__builtin_nontemporal_load((const u2*)yp));
        const bf16* zt = Z + (size_t)tok * ZE_LD + 2560 + hc;
        const f4 vc = bf4(*(const u2*)zt); f4 vpv = (f4){0.f, 0.f, 0.f, 0.f}; if ((tok & (T - 1)) != 0) vpv = bf4(*(const u2*)(zt - ZE_LD));
        const f4 vv = vc + (vpv - vc) * mu_v;
        const float bon = BON[(size_t)tok * 8 + h];
        const float mean = red16((yv.x + yv.y) + (yv.z + yv.w)) * (1.0f / 64.0f);
        const f4 d = yv - mean;
        const float var = red16((d.x * d.x + d.y * d.y) + (d.z * d.z + d.w * d.w)) * (1.0f / 64.0f);
        const float rs = __builtin_amdgcn_rsqf(var + GN_EPS);
        const f4 g = bf4(__builtin_nontemporal_load((const u2*)(G + (size_t)tok * 512 + hc)));
        const f4 o = (d * rs * lnw + lnb + vv * bon) * g;
        u2 w; w.x = pk2(o.x, o.y); w.y = pk2(o.z, o.w);
        *(u2*)yp = w;
    }
}


constexpr size_t WS_BAR = 16384;
#define XB_TMO      128
#define XB_XCNT(j)  (256  + 64 * (j))
#define XB_XSUB(j)  (1280 + 64 * (j))
#define XB_XGEN(j)  (2304 + 64 * (j))
#define XB_TOP      3328
#define XB_TOPGEN   3392
#define XCD_BAR_WORDS 3456
#define XB_SPIN_CAP (1u << 20)
__device__ __forceinline__ unsigned xb_ld(unsigned* p)              { return __hip_atomic_load(p, __ATOMIC_RELAXED, __HIP_MEMORY_SCOPE_AGENT); }
__device__ __forceinline__ unsigned xb_add(unsigned* p, unsigned v) { return __hip_atomic_fetch_add(p, v, __ATOMIC_RELAXED, __HIP_MEMORY_SCOPE_AGENT); }
__device__ __forceinline__ unsigned xb_xcc_id() { return (unsigned)__builtin_amdgcn_s_getreg((3 << 11) | 20) & 0xFu; }
#define XB_SPIN(cond, bar) do { unsigned _sp = 0; while (cond) { \
    if ((++_sp & 255u) == 0u) { if (xb_ld(&(bar)[XB_TMO])) break; if (_sp > XB_SPIN_CAP) { atomicAdd(&(bar)[XB_TMO], 1u); break; } } } } while (0)
__device__ __forceinline__ void xcd_barrier_complete(unsigned* bar, unsigned x, unsigned& nloc, unsigned& nx) {
    const unsigned G = gridDim.x * gridDim.y * gridDim.z;
    unsigned sum, cnt, mine, sp = 0u;
    for (;;) {
        sum = 0u; cnt = 0u; mine = 0u;
#pragma unroll
        for (unsigned j = 0; j < 16; ++j) { const unsigned c = xb_ld(&bar[XB_XCNT(j)]); sum += c; cnt += (c > 0u) ? 1u : 0u; mine = (j == x) ? c : mine; }
        if (sum == G) break;
        __builtin_amdgcn_s_sleep(1);
        if ((++sp & 255u) == 0u) { if (xb_ld(&bar[XB_TMO])) break; if (sp > XB_SPIN_CAP) { atomicAdd(&bar[XB_TMO], 1u); break; } }
    }
    nloc = mine > 0u ? mine : 1u; nx = cnt > 0u ? cnt : 1u;
}
__device__ __forceinline__ void xcd_barrier(unsigned* bar, volatile LAS unsigned* st, bool leader) {
    asm volatile("s_waitcnt vmcnt(0) lgkmcnt(0)" ::: "memory");
    __syncthreads();
    if (leader) {
        const unsigned x = xb_xcc_id();
        __builtin_amdgcn_s_waitcnt(0);
        unsigned nloc = st[0], nx = st[1];
        if (nloc == 0u) { xcd_barrier_complete(bar, x, nloc, nx); st[0] = nloc; st[1] = nx; }
        const unsigned old = xb_add(&bar[XB_XSUB(x)], 1u);
        const unsigned gen = old / nloc;
        if (old + 1u == (gen + 1u) * nloc) {
            __builtin_amdgcn_fence(__ATOMIC_RELEASE, "agent");
            asm volatile("s_waitcnt vmcnt(0)" ::: "memory");
            const unsigned og = xb_add(&bar[XB_TOP], 1u);
            const unsigned tg = og / nx;
            if (og + 1u == (tg + 1u) * nx) xb_add(&bar[XB_TOPGEN], 1u);
            else XB_SPIN(xb_ld(&bar[XB_TOPGEN]) == tg, bar);
            xb_add(&bar[XB_XGEN(x)], 1u);
            __builtin_amdgcn_fence(__ATOMIC_ACQUIRE, "agent");
            asm volatile("s_waitcnt vmcnt(0)" ::: "memory");
        } else {
            XB_SPIN(xb_ld(&bar[XB_XGEN(x)]) == gen, bar);
            __builtin_amdgcn_fence(__ATOMIC_ACQUIRE, "agent");
            asm volatile("s_waitcnt vmcnt(0)" ::: "memory");
        }
    }
    __syncthreads();
}
#define CG_SYNC() do { asm volatile("s_waitcnt vmcnt(0) lgkmcnt(0)" ::: "memory"); grid.sync(); __builtin_amdgcn_fence(__ATOMIC_ACQUIRE, "agent"); asm volatile("s_waitcnt vmcnt(0)" ::: "memory"); } while (0)
#define GRID_SYNC() do { PH_BEGIN xcd_barrier((unsigned*)(ws + WS_BAR), (volatile LAS unsigned*)(lds + LDS_MISC + 512), tid == 0); } while (0)
#define CAS __attribute__((address_space(4)))
typedef const CAS Args KArgs;
#define PH_BEGIN \
    int wave = wave0; asm volatile("" : "+s"(wave)); \
    int lane; asm volatile("v_mbcnt_lo_u32_b32 %0, -1, 0\n\tv_mbcnt_hi_u32_b32 %0, -1, %0" : "=v"(lane)); const int tid = wave * 64 + lane; \
    const int NG = gridDim.x, bid = blockIdx.x, gw = bid * NWAVES + wave, NGW = NG * NWAVES; \
    const CAS Args* Ap_ = (const CAS Args*)__builtin_amdgcn_kernarg_segment_ptr(); asm volatile("" : "+s"(Ap_)); KArgs& A = *Ap_; \
    unsigned char* ws = A.ws; (void)lane; (void)gw; (void)NGW; (void)tid; (void)wave; (void)bid; (void)ws;
#define P_WIN ((bf16*)(ws + WS_WIN))
#define P_WOUT ((bf16*)(ws + WS_WOUT))
#define P_WUP ((bf16*)(ws + WS_WUP))
#define P_WDN ((bf16*)(ws + WS_WDN))
#define P_H ((bf16*)(ws + WS_H))
#define P_Y ((bf16*)(ws + WS_Y))
#define P_Z ((bf16*)(ws + WS_Z))
#define P_CS ((float*)(ws + WS_CS))
#define P_C2 ((float*)(ws + WS_C2))
#define P_ML ((float*)(ws + WS_ML))
#define P_AUX ((bf16*)(ws + WS_A))
#define P_MB ((bf16*)(ws + WS_Z))
#define P_CTL ((unsigned*)(ws + WS_CTL))


#ifndef DBG_COL
#define DBG_COL 0
#endif
#ifndef DBG_STOP
#define DBG_STOP 0
#endif
#ifndef DBG_LAYER
#define DBG_LAYER 0
#endif
__device__ __forceinline__ void dbg_dump_bf16(const bf16* src, int ld, int col0, float* out, int gw, int NGW, int lane) {
    for (int row = gw; row < M; row += NGW) for (int c = lane; c < 1024; c += 64) { float v = bf2f(src[(size_t)row * ld + col0 + c]); if (DBG_STOP == 49 && !(fabsf(v) < 1e30f)) v = 12345.0f; out[(size_t)row * 1024 + c] = v; }
}
__device__ __forceinline__ void dbg_dump_f32(const float* src, int ld, int col0, int ncol, float* out, int gw, int NGW, int lane) {
    for (int row = gw; row < M; row += NGW) for (int c = lane; c < 1024; c += 64) out[(size_t)row * 1024 + c] = (c < ncol) ? src[(size_t)row * ld + col0 + c] : 0.f;
}
#define DBG_AT(k, stmt) do { if (DBG_STOP == (k) && layer == DBG_LAYER) { { PH_BEGIN stmt; } asm volatile("s_waitcnt vmcnt(0)" ::: "memory"); __builtin_amdgcn_endpgm(); } } while (0)

template <int layer> __device__ __forceinline__ void layer_body(LAS unsigned char* lds, const int wave0) {
    cg::grid_group grid = cg::this_grid();
    constexpr int i = layer >> 1; constexpr bool even = (layer & 1) == 0;
    if constexpr (even) {
        {
            PH_BEGIN
            pg8::Gemm g{P_H, P_WIN, M, 3584, 1024, 0}; pg8::StaticOrder S; S.init(M, 3584, NG, bid); pg8::EpiZ E{P_Z, ZE_LD, ZE_LD, nullptr, 0};
            pg8::gemm_phase<pg8::EpiZ, pg8::StaticOrder, true, true>(lds, g, S, E, tid);
        }
        GRID_SYNC();
        DBG_AT(2, dbg_dump_bf16(P_Z, ZE_LD, DBG_COL, A.out, gw, NGW, lane));
        {
            PH_BEGIN
            fox_kmax(ws, i, gw, NGW, lane);
            rwkv_prep(A, i, gw, NGW, lane);
            if (bid < NB) fox_cumsum(A, i, bid, lds, tid, wave, lane);
        }
        GRID_SYNC();
        DBG_AT(3, dbg_dump_f32((const float*)(ws + WS_A + 128 * MiB), 512, 0, 512, A.out, gw, NGW, lane));
        DBG_AT(31, dbg_dump_bf16((const bf16*)(ws + WS_A), 512, 0, A.out, gw, NGW, lane));
        DBG_AT(32, dbg_dump_f32(P_C2, 8, 0, 8, A.out, gw, NGW, lane));
        {
            PH_BEGIN
            LAS int* jobw = (LAS int*)(lds + LDS_MISC);
            for (;;) {
                __syncthreads();
                if (tid == 0) *jobw = (int)atomicAdd(P_CTL + 64 * i, 1u);
                __syncthreads();
                const int j = *jobw;
                if (j >= 128 + 2048) break;
                if (j < 128) scan_job(A, i, j >> 4, (j >> 1) & 7, j & 1, lds, tid);
                else {
                    const int jj = j - 128, qb = 31 - (jj >> 6), bh = jj & 63, b = bh >> 3, h = bh & 7;
                    AttnP P; P.q = P_Z + (size_t)b * T * ZE_LD + 64 * h; P.k = P.q + 512; P.v = P.q + 1024; P.ld = ZE_LD; P.stride = 1; P.resid = 0;
                    P.qi0 = 256 * qb; P.kbase = 0; P.jt0 = 0; P.jt1 = 4 * (qb + 1); P.W = 1 << 30; P.c2 = P_C2 + (size_t)b * T * 8 + h; P.kmax = sqrtf(__builtin_bit_cast(float, P_CTL[256 + 64 * i + b * 8 + h])); P.oacc = nullptr; P.ml = nullptr; P.load_state = 0; P.final = 1;
                    P.y = P_Y + (size_t)b * T * 1024 + 64 * h;
                    attn_unit<true>(P, lds, tid, wave, lane);
                }
            }
        }
        GRID_SYNC();
        {
            PH_BEGIN
            rwkv_post(A, i, bid * (NWAVES * 64) + tid, NG * NWAVES * 64);
        }
        GRID_SYNC();
        DBG_AT(4, dbg_dump_bf16(P_Y, 1024, 0, A.out, gw, NGW, lane));
    } else {
        {
            PH_BEGIN
            pg8::Gemm g{P_H, P_WIN, M, 3072, 1024, 0}; pg8::StaticOrder S; S.init(M, 3072, NG, bid); pg8::EpiZ E{P_Z, ZO_LD, ZO_LD, P_CS, 2048};
            pg8::gemm_phase<pg8::EpiZ, pg8::StaticOrder, true, true>(lds, g, S, E, tid);
        }
        GRID_SYNC();
        DBG_AT(2, dbg_dump_bf16(P_Z, ZO_LD, DBG_COL, A.out, gw, NGW, lane));
        {
            PH_BEGIN
            for (int job = bid; job < NB * 16 * 2; job += NG) {
                const int b = job >> 5, h = (job >> 1) & 15, R = job & 1;
#pragma unroll 1
                for (int gi = 0; gi < 3; ++gi) {
                    const int dl = (gi == 0) ? 1 : (gi == 1 ? 4 : 16);
#pragma unroll 1
                    for (int u = 0; u < 16; ++u) {
                        const int r = (gi == 0) ? 0 : (gi == 1 ? (u >> 2) : u), n2 = (gi == 0) ? (16 * R + u) : (gi == 1 ? (4 * R + (u & 3)) : R);
                        AttnP P; P.q = P_Z + (size_t)b * T * ZO_LD + 64 * h; P.k = P.q + 1024; P.v = P.q + 2048; P.ld = ZO_LD; P.stride = dl; P.resid = r;
                        P.qi0 = 256 * n2; P.kbase = P.qi0 - 128; P.jt0 = (n2 == 0) ? 2 : 0; P.jt1 = 6; P.W = 128; P.c2 = nullptr; P.kmax = 0.f;
                        P.oacc = P_AUX + (size_t)b * T * 1024 + 64 * h; P.ml = P_ML + (size_t)b * T * 32 + 2 * h; P.load_state = gi > 0; P.final = gi == 2;
                        P.y = P_Y + (size_t)b * T * 1024 + 64 * h;
                        attn_band_unit(P, lds, tid, wave, lane);
                    }
                    asm volatile("s_waitcnt vmcnt(0)" ::: "memory"); __syncthreads();
                    if (tid == 0) { __builtin_amdgcn_fence(__ATOMIC_ACQUIRE, "agent"); asm volatile("s_waitcnt vmcnt(0)" ::: "memory"); }
                    __syncthreads();
                }
            }
        }
        GRID_SYNC();
        DBG_AT(4, dbg_dump_bf16(P_Y, 1024, 0, A.out, gw, NGW, lane));
    }
    {
        PH_BEGIN
        pg8::Gemm g{P_Y, P_WOUT, M, 1024, 1024, 0}; pg8::StaticOrder S; S.init(M, 1024, NG, bid); pg8::EpiZ E{P_MB, 1024, 1024, nullptr, 0};
        pg8::gemm_phase<pg8::EpiZ, pg8::StaticOrder, true, true>(lds, g, S, E, tid);
    }
    GRID_SYNC();
    DBG_AT(5, dbg_dump_bf16(P_MB, 1024, 0, A.out, gw, NGW, lane));
    {
        PH_BEGIN
        row_phase((layer == 0) ? A.in[0] : A.out, P_MB, A.in[3] + layer * D, A.out, A.in[4] + layer * D, P_H, gw, NGW, lane);
    }
    GRID_SYNC();
    DBG_AT(6, (void)0);
    {
        PH_BEGIN
        pg8::Gemm g{P_H, P_WUP, 264 * 256, 5632, 1024, 1}; pg8::StaticOrder S; S.init(264 * 256, 5632, NG, bid);
        pg8::EpiConv E{P_Z, A.in[23] + (size_t)layer * 3 * 5632, A.in[24] + (size_t)layer * 5632, (LAS float*)(lds + LDS_X)};
        pg8::gemm_phase<pg8::EpiConv, pg8::StaticOrder, true, true>(lds, g, S, E, tid);
    }
    GRID_SYNC();
    DBG_AT(7, dbg_dump_bf16(P_Z, 2816, DBG_COL, A.out, gw, NGW, lane));
    {
        PH_BEGIN
        pg8::Gemm g{P_Z, P_WDN, M, 1024, FF, 0}; pg8::StaticOrder S; S.init(M, 1024, NG, bid); pg8::EpiZ E{P_AUX, 1024, 1024, nullptr, 0};
        pg8::gemm_phase<pg8::EpiZ, pg8::StaticOrder, true, true>(lds, g, S, E, tid);
    }
    GRID_SYNC();
    DBG_AT(8, dbg_dump_bf16(P_AUX, 1024, 0, A.out, gw, NGW, lane));
    {
        PH_BEGIN
        if constexpr (layer + 1 < DEPTH) { row_phase(A.out, P_AUX, A.in[5] + layer * D, A.out, A.in[2] + (layer + 1) * D, P_H, gw, NGW, lane); convert_layer_weights(A, layer + 1, lds, gw, NGW, wave, lane); }
        else row_phase(A.out, P_AUX, A.in[5] + layer * D, A.out, nullptr, nullptr, gw, NGW, lane);
    }
    if constexpr (layer + 1 < DEPTH) GRID_SYNC();
    DBG_AT(9, (void)0);
}

__global__ void __launch_bounds__(NWAVES * 64, 2) mega_fwd(Args Aarg) {
    extern __shared__ __attribute__((aligned(16))) unsigned char lds_raw[];
    LAS unsigned char* lds = (LAS unsigned char*)lds_raw;
    cg::grid_group grid = cg::this_grid();
    const int wave0 = __builtin_amdgcn_readfirstlane((int)threadIdx.x >> 6);
    {
        PH_BEGIN
        if (tid == 0) { volatile LAS unsigned* st = (volatile LAS unsigned*)(lds + LDS_MISC + 512); st[0] = 0u; st[1] = 0u; (void)xb_add((unsigned*)(ws + WS_BAR) + XB_XCNT(xb_xcc_id()), 1u); }
    }
    {
        PH_BEGIN
        convert_layer_weights(A, 0, lds, gw, NGW, wave, lane);
        const int* pos = (const int*)A.in[1];
        for (int idx = bid * (NWAVES * 64) + tid; idx < M * 8; idx += NG * NWAVES * 64) {
            const int tok = idx >> 3, d = idx & 7;
            const float ang = (float)pos[tok] * A.inv_freq[d];
            const double rev = (double)ang * 0.15915494309189535; const float fr = (float)(rev - __builtin_rint(rev));
            P_CS[(size_t)tok * 16 + d] = __builtin_amdgcn_cosf(fr); P_CS[(size_t)tok * 16 + 8 + d] = __builtin_amdgcn_sinf(fr);
        }
        row_phase(A.in[0], nullptr, nullptr, nullptr, A.in[2], P_H, gw, NGW, lane);
        if (bid == 0) P_CTL[tid] = 0u;
        if (A.out == nullptr) CG_SYNC();
    }
    GRID_SYNC();
    layer_body<0>(lds, wave0); layer_body<1>(lds, wave0); layer_body<2>(lds, wave0); layer_body<3>(lds, wave0);
}

extern "C" void kernel_launch(void* const* d_in, const int* in_sizes, int n_in, void* d_out, int out_size, void* d_ws, size_t ws_size, hipStream_t stream) {
    static int grid = 0;
    if (grid == 0) {
        if (n_in != 26 || out_size != M * D || ws_size < WS_END) { fprintf(stderr, "kernel_launch: unexpected problem (n_in %d out %d ws %zu need %zu)\n", n_in, out_size, ws_size, (size_t)WS_END); grid = -1; return; }
        int dev = 0, cus = 0, per_cu = 0;
        hipGetDevice(&dev); hipDeviceGetAttribute(&cus, hipDeviceAttributeMultiprocessorCount, dev);
        if (hipFuncSetAttribute((const void*)mega_fwd, hipFuncAttributeMaxDynamicSharedMemorySize, LDS_BYTES) != hipSuccess) { fprintf(stderr, "kernel_launch: hipFuncSetAttribute failed\n"); grid = -1; return; }
        hipOccupancyMaxActiveBlocksPerMultiprocessor(&per_cu, (const void*)mega_fwd, NWAVES * 64, LDS_BYTES);
        if (per_cu < 1) { fprintf(stderr, "kernel_launch: occupancy query says %d blocks per CU\n", per_cu); per_cu = 1; }
        (void)hipGetLastError();
        grid = cus * 1;
    }
    if (grid < 0) return;
    if (hipMemsetAsync((char*)d_ws + WS_BAR, 0, XCD_BAR_WORDS * 4, stream) != hipSuccess) { fprintf(stderr, "kernel_launch: hipMemsetAsync failed\n"); return; }
    Args a{};
    for (int i = 0; i < 26; ++i) a.in[i] = (const float*)d_in[i];
    a.out = (float*)d_out; a.ws = (unsigned char*)d_ws;
    for (int d = 0; d < 8; ++d) a.inv_freq[d] = (float)pow(500000.0, -(double)(2 * d) / 16.0);
    void* args[] = {&a};
    hipError_t e = hipLaunchCooperativeKernel((const void*)mega_fwd, dim3(grid), dim3(NWAVES * 64), args, LDS_BYTES, stream);
    if (e != hipSuccess) fprintf(stderr, "cooperative launch failed: %s (grid %d)\n", hipGetErrorString(e), grid);
}
```
